# Optimizing an MI355X kernel written in HIP

```python
import math
import jax
import jax.numpy as jnp
from jax import lax
import numpy as np

D_MODEL = 1024
BATCH = 8
SEQ = 2048
DEPTH = 4
DEC_BATCH = 128
DEC_SEQ = 1
PAST_LEN = 16384
PAGE_SIZE = 128

D_MIX = D_MODEL
D_BRANCH = D_MIX // 4
HEAD_DIM = 64
N_HEADS = D_BRANCH // HEAD_DIM
GLA_GATE_RANK = 16
GLA_TAU = 16.0
GLA_CHUNK = 16
S5_CH = 16
S5_GROUPS = D_BRANCH // S5_CH
S5_STATE = 64
GDN_CONV = 4
GDN_CHUNK = 64
RWKV_LORA_W = 64
RWKV_LORA_A = 64
RWKV_SHIFT_W = 3 * D_BRANCH + RWKV_LORA_W + RWKV_LORA_A
RMS_EPS = 1e-6
L2_EPS = 1e-6
RWKV_GN_EPS = 64e-5
IN_SIZES = (D_BRANCH, D_BRANCH, D_BRANCH, GLA_GATE_RANK, D_BRANCH,
            D_BRANCH, D_BRANCH,
            3 * D_BRANCH, N_HEADS, N_HEADS, D_BRANCH,
            RWKV_SHIFT_W, D_BRANCH)
D_IN = sum(IN_SIZES)
F32 = jnp.float32

kernel_name = 'hybrid_gla_s5_gdn_rwkv7_step'


def rms_norm(x, g):
    xf = x.astype(F32)
    y = xf * lax.rsqrt(jnp.mean(xf * xf, axis=-1, keepdims=True) + RMS_EPS) * g.astype(F32)
    return y.astype(x.dtype)


def head_rms(o, g):
    return o * lax.rsqrt(jnp.mean(o * o, axis=-1, keepdims=True) + RMS_EPS) * g.astype(F32)


def l2norm(t):
    return t * lax.rsqrt(jnp.sum(t * t, axis=-1, keepdims=True) + L2_EPS)


def heads(t):
    return t.reshape(t.shape[:-1] + (N_HEADS, HEAD_DIM))


def to_blocks(t, c):
    b, l = t.shape[:2]
    t = t.reshape((b, l // c, c) + t.shape[2:])
    return t.transpose((1, 0, 3, 2) + tuple(range(4, t.ndim)))


def from_blocks(t):
    n, b, h, c, d = t.shape
    return t.transpose(1, 0, 3, 2, 4).reshape(b, n * c, h, d)


def gla_mix(q, k, v, log_a, s0):
    seq = q.shape[1]
    c = math.gcd(seq, GLA_CHUNK)
    q = to_blocks(q * (HEAD_DIM ** -0.5), c)
    k, v, log_a = to_blocks(k, c), to_blocks(v, c), to_blocks(log_a, c)
    cum = jnp.cumsum(log_a, axis=-2)
    causal = jnp.tril(jnp.ones((c, c), bool))
    diff = cum[..., :, None, :] - cum[..., None, :, :]
    decay = jnp.exp(jnp.where(causal[:, :, None], diff, -jnp.inf))
    attn = jnp.einsum('nbhid,nbhjd,nbhijd->nbhij', q, k, decay)
    o_intra = jnp.einsum('nbhij,nbhjv->nbhiv', attn, v)
    q_dec = q * jnp.exp(cum)
    k_dec = k * jnp.exp(cum[..., -1:, :] - cum)
    a_tot = jnp.exp(cum[..., -1, :])

    def step(s, inp):
        qd, kd, vv, at = inp
        o = jnp.einsum('bhcd,bhdv->bhcv', qd, s)
        s = at[..., None] * s + jnp.einsum('bhcd,bhcv->bhdv', kd, vv)
        return s, o

    s_fin, o_inter = lax.scan(step, s0, (q_dec, k_dec, v, a_tot))
    return from_blocks(o_intra + o_inter), s_fin


def gdn_mix(q, k, v, g, beta, s0):
    seq = q.shape[1]
    c = math.gcd(seq, GDN_CHUNK)
    q = to_blocks(q * (HEAD_DIM ** -0.5), c)
    k, v = to_blocks(k, c), to_blocks(v, c)
    g, beta = to_blocks(g, c), to_blocks(beta, c)
    gc = jnp.cumsum(g, axis=-1)
    causal = jnp.tril(jnp.ones((c, c), bool))
    strict = jnp.tril(jnp.ones((c, c), bool), -1)
    decay = jnp.exp(jnp.where(causal, gc[..., :, None] - gc[..., None, :], -jnp.inf))
    kb = k * beta[..., None]
    vb = v * beta[..., None]
    low = jnp.where(strict, jnp.einsum('nbhid,nbhjd->nbhij', kb, k) * decay, 0.0)
    tmat = low + jnp.eye(c, dtype=low.dtype)
    rhs = jnp.concatenate([vb, kb * jnp.exp(gc)[..., None]], axis=-1)
    sol = lax.linalg.triangular_solve(tmat, rhs, left_side=True, lower=True, unit_diagonal=True)
    u, w = sol[..., :HEAD_DIM], sol[..., HEAD_DIM:]
    attn = jnp.einsum('nbhid,nbhjd->nbhij', q, k) * decay
    q_dec = q * jnp.exp(gc)[..., None]
    k_dec = k * jnp.exp(gc[..., -1:] - gc)[..., None]
    g_tot = jnp.exp(gc[..., -1])

    def step(s, inp):
        uu, ww, qd, kd, at, gt = inp
        v_new = uu - jnp.einsum('bhcd,bhdv->bhcv', ww, s)
        o = jnp.einsum('bhcd,bhdv->bhcv', qd, s) + jnp.einsum('bhij,bhjv->bhiv', at, v_new)
        s = gt[..., None, None] * s + jnp.einsum('bhcd,bhcv->bhdv', kd, v_new)
        return s, o

    s_fin, o = lax.scan(step, s0, (u, w, q_dec, k_dec, attn, g_tot))
    return from_blocks(o), s_fin


def s5_mix(u, lam_re, lam_im, log_step, b_re, b_im, c_re, c_im, d, h0_re, h0_im):
    bsz, seq, _ = u.shape
    lam_re, lam_im = lam_re.astype(F32), lam_im.astype(F32)
    step = jnp.exp(log_step.astype(F32))[:, None]
    mag = jnp.exp(lam_re * step)
    ab_re = mag * jnp.cos(lam_im * step)
    ab_im = mag * jnp.sin(lam_im * step)
    den = lam_re * lam_re + lam_im * lam_im
    z_re = ((ab_re - 1.0) * lam_re + ab_im * lam_im) / den
    z_im = (ab_im * lam_re - (ab_re - 1.0) * lam_im) / den
    b_re, b_im = b_re.astype(F32), b_im.astype(F32)
    bb_re = z_re[..., None] * b_re - z_im[..., None] * b_im
    bb_im = z_re[..., None] * b_im + z_im[..., None] * b_re
    ug = u.reshape(bsz, seq, S5_GROUPS, S5_CH)
    bu_re = jnp.einsum('blgc,gpc->blgp', ug, bb_re)
    bu_im = jnp.einsum('blgc,gpc->blgp', ug, bb_im)
    a_re = jnp.broadcast_to(ab_re, bu_re.shape)
    a_im = jnp.broadcast_to(ab_im, bu_im.shape)

    def combine(e1, e2):
        a1r, a1i, b1r, b1i = e1
        a2r, a2i, b2r, b2i = e2
        return (a1r * a2r - a1i * a2i, a1r * a2i + a1i * a2r,
                a2r * b1r - a2i * b1i + b2r, a2r * b1i + a2i * b1r + b2i)

    cum_re, cum_im, hs_re, hs_im = lax.associative_scan(combine, (a_re, a_im, bu_re, bu_im), axis=1)
    h0_re = h0_re.astype(F32)[:, None]
    h0_im = h0_im.astype(F32)[:, None]
    h_re = hs_re + cum_re * h0_re - cum_im * h0_im
    h_im = hs_im + cum_re * h0_im + cum_im * h0_re
    y = (jnp.einsum('blgp,gcp->blgc', h_re, c_re.astype(F32))
         - jnp.einsum('blgp,gcp->blgc', h_im, c_im.astype(F32)))
    y = y.reshape(bsz, seq, D_BRANCH) + d.astype(F32) * u
    return y, h_re[:, -1], h_im[:, -1]


def rwkv7_mix(r, log_w, k, v, kk, a, s0):
    def step(s, inp):
        r_t, lw_t, k_t, v_t, kk_t, a_t = inp
        s = (s * jnp.exp(lw_t)[:, :, None, :]
             - jnp.einsum('bhvi,bhi->bhv', s, kk_t)[..., None] * (kk_t * a_t)[:, :, None, :]
             + v_t[..., None] * k_t[:, :, None, :])
        return s, jnp.einsum('bhvk,bhk->bhv', s, r_t)

    xs = tuple(t.transpose(1, 0, 2, 3) for t in (r, log_w, k, v, kk, a))
    s_fin, o = lax.scan(step, s0, xs)
    return o.transpose(1, 0, 2, 3), s_fin


def hybrid_layer(x, st, lp):
    (norm_g, w_in, gla_wg2, gla_bg, gla_norm_g,
     s5_lam_re, s5_lam_im, s5_log_step, s5_b_re, s5_b_im, s5_c_re, s5_c_im, s5_d, s5_w_glu, s5_b_glu,
     gdn_conv_w, gdn_a_log, gdn_dt_bias, gdn_norm_g,
     rwkv_mu, rwkv_w0, rwkv_ww2, rwkv_a0, rwkv_wa2, rwkv_k_k, rwkv_k_a, rwkv_r_k, rwkv_ln_g, rwkv_ln_b,
     w_out) = lp
    st_gla, st_s5_re, st_s5_im, st_gdn, st_conv, st_rwkv, st_shift = st
    bsz, seq, _ = x.shape
    h = rms_norm(x, norm_g)
    proj = jnp.matmul(h, w_in).astype(F32)
    split_at = np.cumsum(IN_SIZES)[:-1].tolist()
    (gla_q, gla_k, gla_v, gla_glr, gla_gate, s5_u, s5_gate,
     gdn_qkv, gdn_a, gdn_b, gdn_gate, rwkv_in, rwkv_gate) = jnp.split(proj, split_at, axis=-1)

    log_a = jax.nn.log_sigmoid(gla_glr @ gla_wg2.astype(F32) + gla_bg) / GLA_TAU
    o, new_gla = gla_mix(heads(gla_q), heads(gla_k), heads(gla_v), heads(log_a), st_gla.astype(F32))
    o_gla = head_rms(o, gla_norm_g).reshape(bsz, seq, D_BRANCH) * jax.nn.silu(gla_gate)

    y, new_s5_re, new_s5_im = s5_mix(s5_u, s5_lam_re, s5_lam_im, s5_log_step, s5_b_re, s5_b_im,
                                     s5_c_re, s5_c_im, s5_d, st_s5_re, st_s5_im)
    y = jax.nn.gelu(y)
    y = y * jax.nn.sigmoid(y @ s5_w_glu.astype(F32) + s5_b_glu)
    o_s5 = y * jax.nn.silu(s5_gate)

    xp = jnp.concatenate([st_conv.astype(F32), gdn_qkv], axis=1)
    conv = xp[:, 0:seq] * gdn_conv_w[0]
    for j in range(1, GDN_CONV):
        conv = conv + xp[:, j:j + seq] * gdn_conv_w[j]
    new_conv = xp[:, seq:]
    gq, gk, gv = jnp.split(jax.nn.silu(conv), 3, axis=-1)
    g = -jnp.exp(gdn_a_log.astype(F32)) * jax.nn.softplus(gdn_a + gdn_dt_bias)
    beta = jax.nn.sigmoid(gdn_b)
    o, new_gdn = gdn_mix(l2norm(heads(gq)), l2norm(heads(gk)), heads(gv), g, beta, st_gdn.astype(F32))
    o_gdn = head_rms(o, gdn_norm_g).reshape(bsz, seq, D_BRANCH) * jax.nn.silu(gdn_gate)

    prev = jnp.concatenate([st_shift.astype(F32)[:, None], rwkv_in[:, :-1]], axis=1)
    xs = rwkv_in + (prev - rwkv_in) * rwkv_mu
    new_shift = rwkv_in[:, -1]
    rr, rk, rv, rwl, ral = jnp.split(xs, np.cumsum([D_BRANCH, D_BRANCH, D_BRANCH, RWKV_LORA_W]).tolist(), axis=-1)
    w = -jax.nn.softplus(-(rwkv_w0 + jnp.tanh(rwl) @ rwkv_ww2.astype(F32))) - 0.5
    log_w = -jnp.exp(w)
    a = jax.nn.sigmoid(rwkv_a0 + ral @ rwkv_wa2.astype(F32))
    kk = l2norm(heads(rk * rwkv_k_k))
    rk = rk * (1.0 + (a - 1.0) * rwkv_k_a)
    r_h, k_h, v_h = heads(rr), heads(rk), heads(rv)
    o, new_rwkv = rwkv7_mix(r_h, heads(log_w), k_h, v_h, kk, heads(a), st_rwkv.astype(F32))
    mu = jnp.mean(o, axis=-1, keepdims=True)
    var = jnp.mean(jnp.square(o - mu), axis=-1, keepdims=True)
    o = ((o - mu) * lax.rsqrt(var + RWKV_GN_EPS)).reshape(bsz, seq, D_BRANCH) * rwkv_ln_g + rwkv_ln_b
    bonus = jnp.sum(r_h * k_h * rwkv_r_k, axis=-1, keepdims=True) * v_h
    o_rwkv = (o + bonus.reshape(bsz, seq, D_BRANCH)) * jax.nn.silu(rwkv_gate)

    mixed = jnp.concatenate([o_gla, o_s5, o_gdn, o_rwkv], axis=-1)
    out = jnp.matmul(mixed, w_out.astype(F32))
    return x + out.astype(x.dtype), (new_gla, new_s5_re, new_s5_im, new_gdn, new_conv, new_rwkv, new_shift)


def run_trunk(x, init_state, layer_params, final_g):
    new = [[] for _ in init_state]
    for layer in range(DEPTH):
        x, st = hybrid_layer(x, tuple(s[layer] for s in init_state), tuple(w[layer] for w in layer_params))
        for acc, s in zip(new, st):
            acc.append(s)
    return rms_norm(x, final_g), tuple(jnp.stack(acc) for acc in new)


def setup_inputs(seed: int = 0) -> dict:
    key = jax.random.key(seed)
    ks = iter(jax.random.split(key, 48))

    def nrm(shape, scale):
        return jax.random.normal(next(ks), shape, F32) * scale

    def uni(shape, lo, hi):
        return jax.random.uniform(next(ks), shape, F32, lo, hi)

    L = DEPTH
    mat = (L, DEC_BATCH, N_HEADS, HEAD_DIM, HEAD_DIM)
    x_prompt = nrm((BATCH, SEQ, D_MODEL), 1.0)
    x_sample = nrm((DEC_BATCH, DEC_SEQ, D_MODEL), 1.0)
    state_gla = nrm(mat, 2.0)
    state_s5_re = nrm((L, DEC_BATCH, S5_GROUPS, S5_STATE), 0.1)
    state_s5_im = nrm((L, DEC_BATCH, S5_GROUPS, S5_STATE), 0.1)
    state_gdn = nrm(mat, 0.3)
    state_gdn_conv = nrm((L, DEC_BATCH, GDN_CONV - 1, 3 * D_BRANCH), 1.0)
    state_rwkv = nrm(mat, 0.5)
    state_rwkv_shift = nrm((L, DEC_BATCH, RWKV_SHIFT_W), 1.0)
    norm_g = 1.0 + nrm((L, D_MODEL), 0.02)
    w_in = nrm((L, D_MODEL, D_IN), D_MODEL ** -0.5)
    gla_wg2 = nrm((L, GLA_GATE_RANK, D_BRANCH), GLA_GATE_RANK ** -0.5)
    gla_bg = uni((L, D_BRANCH), 1.0, 3.0)
    gla_norm_g = 1.0 + nrm((L, HEAD_DIM), 0.02)
    s5_lam_re = -0.5 + nrm((L, S5_GROUPS, S5_STATE), 0.01)
    s5_lam_im = math.pi * jnp.arange(S5_STATE, dtype=F32) + nrm((L, S5_GROUPS, S5_STATE), 0.01)
    s5_log_step = uni((L, S5_GROUPS), math.log(1e-3), math.log(1e-1))
    s5_b_re = nrm((L, S5_GROUPS, S5_STATE, S5_CH), (2 * S5_CH) ** -0.5)
    s5_b_im = nrm((L, S5_GROUPS, S5_STATE, S5_CH), (2 * S5_CH) ** -0.5)
    s5_c_re = nrm((L, S5_GROUPS, S5_CH, S5_STATE), S5_STATE ** -0.5)
    s5_c_im = nrm((L, S5_GROUPS, S5_CH, S5_STATE), S5_STATE ** -0.5)
    s5_d = nrm((L, D_BRANCH), 1.0)
    s5_w_glu = nrm((L, D_BRANCH, D_BRANCH), D_BRANCH ** -0.5)
    s5_b_glu = nrm((L, D_BRANCH), 0.02)
    gdn_conv_w = nrm((L, GDN_CONV, 3 * D_BRANCH), GDN_CONV ** -0.5)
    gdn_a_log = jnp.log(uni((L, N_HEADS), 1.0, 16.0))
    dt = jnp.exp(uni((L, N_HEADS), math.log(1e-3), math.log(1e-1)))
    gdn_dt_bias = dt + jnp.log(-jnp.expm1(-dt))
    gdn_norm_g = 1.0 + nrm((L, HEAD_DIM), 0.02)
    rwkv_mu = uni((L, RWKV_SHIFT_W), 0.0, 1.0)
    rwkv_w0 = uni((L, D_BRANCH), -6.5, -1.5)
    rwkv_ww2 = nrm((L, RWKV_LORA_W, D_BRANCH), 0.1)
    rwkv_a0 = nrm((L, D_BRANCH), 0.1)
    rwkv_wa2 = nrm((L, RWKV_LORA_A, D_BRANCH), RWKV_LORA_A ** -0.5)
    rwkv_k_k = 0.85 + nrm((L, D_BRANCH), 0.02)
    rwkv_k_a = 1.0 + nrm((L, D_BRANCH), 0.02)
    rwkv_r_k = nrm((L, N_HEADS, HEAD_DIM), 0.1)
    rwkv_ln_g = 1.0 + nrm((L, D_BRANCH), 0.02)
    rwkv_ln_b = nrm((L, D_BRANCH), 0.02)
    w_out = nrm((L, D_MIX, D_MODEL), 0.5 * D_MIX ** -0.5)
    final_g = 1.0 + nrm((D_MODEL,), 0.02)
    return {'x_prompt': x_prompt, 'x_sample': x_sample,
            'state_gla': state_gla, 'state_s5_re': state_s5_re, 'state_s5_im': state_s5_im,
            'state_gdn': state_gdn, 'state_gdn_conv': state_gdn_conv,
            'state_rwkv': state_rwkv, 'state_rwkv_shift': state_rwkv_shift,
            'norm_g': norm_g, 'w_in': w_in, 'gla_wg2': gla_wg2, 'gla_bg': gla_bg, 'gla_norm_g': gla_norm_g,
            's5_lam_re': s5_lam_re, 's5_lam_im': s5_lam_im, 's5_log_step': s5_log_step,
            's5_b_re': s5_b_re, 's5_b_im': s5_b_im, 's5_c_re': s5_c_re, 's5_c_im': s5_c_im,
            's5_d': s5_d, 's5_w_glu': s5_w_glu, 's5_b_glu': s5_b_glu,
            'gdn_conv_w': gdn_conv_w, 'gdn_a_log': gdn_a_log, 'gdn_dt_bias': gdn_dt_bias, 'gdn_norm_g': gdn_norm_g,
            'rwkv_mu': rwkv_mu, 'rwkv_w0': rwkv_w0, 'rwkv_ww2': rwkv_ww2, 'rwkv_a0': rwkv_a0,
            'rwkv_wa2': rwkv_wa2, 'rwkv_k_k': rwkv_k_k, 'rwkv_k_a': rwkv_k_a, 'rwkv_r_k': rwkv_r_k,
            'rwkv_ln_g': rwkv_ln_g, 'rwkv_ln_b': rwkv_ln_b,
            'w_out': w_out, 'final_g': final_g}


def reference(x_prompt, x_sample, state_gla, state_s5_re, state_s5_im, state_gdn, state_gdn_conv,
              state_rwkv, state_rwkv_shift, norm_g, w_in, gla_wg2, gla_bg, gla_norm_g,
              s5_lam_re, s5_lam_im, s5_log_step, s5_b_re, s5_b_im, s5_c_re, s5_c_im, s5_d, s5_w_glu, s5_b_glu,
              gdn_conv_w, gdn_a_log, gdn_dt_bias, gdn_norm_g,
              rwkv_mu, rwkv_w0, rwkv_ww2, rwkv_a0, rwkv_wa2, rwkv_k_k, rwkv_k_a, rwkv_r_k, rwkv_ln_g, rwkv_ln_b,
              w_out, final_g):
    layer_params = (norm_g, w_in, gla_wg2, gla_bg, gla_norm_g,
                    s5_lam_re, s5_lam_im, s5_log_step, s5_b_re, s5_b_im, s5_c_re, s5_c_im, s5_d, s5_w_glu, s5_b_glu,
                    gdn_conv_w, gdn_a_log, gdn_dt_bias, gdn_norm_g,
                    rwkv_mu, rwkv_w0, rwkv_ww2, rwkv_a0, rwkv_wa2, rwkv_k_k, rwkv_k_a, rwkv_r_k, rwkv_ln_g, rwkv_ln_b,
                    w_out)
    sample_state = (state_gla, state_s5_re, state_s5_im, state_gdn, state_gdn_conv, state_rwkv, state_rwkv_shift)
    prompt_state = tuple(jnp.zeros((DEPTH, x_prompt.shape[0]) + s.shape[2:], F32) for s in sample_state)
    y_prompt, (gla_p, s5_re_p, s5_im_p, gdn_p, gdn_conv_p, rwkv_p, rwkv_shift_p) = run_trunk(
        x_prompt, prompt_state, layer_params, final_g)
    y_sample, (gla_s, s5_re_s, s5_im_s, gdn_s, gdn_conv_s, rwkv_s, rwkv_shift_s) = run_trunk(
        x_sample, sample_state, layer_params, final_g)
    return (y_prompt, y_sample,
            gla_p, s5_re_p, s5_im_p, gdn_p, gdn_conv_p, rwkv_p, rwkv_shift_p,
            gla_s, s5_re_s, s5_im_s, gdn_s, gdn_conv_s, rwkv_s, rwkv_shift_s)
```

```cpp
#include <hip/hip_runtime.h>
#include <hip/hip_cooperative_groups.h>
#include <cstdio>
#include <cstring>
namespace cg = cooperative_groups;

#ifndef COOP
#define COOP 1
#endif
#define DUP_S (-1)
#define PER (DUP_S >= 0 ? 6 : 5)
#define NPH (4 * PER + 1)

typedef unsigned short u16;
typedef __attribute__((ext_vector_type(8))) short bf16x8;
typedef __attribute__((ext_vector_type(4))) short bf16x4;
typedef __attribute__((ext_vector_type(4))) float f32x4;
#define DI __device__ __forceinline__
#define MFMA16(a, b, c) __builtin_amdgcn_mfma_f32_16x16x32_bf16((a), (b), (c), 0, 0, 0)

constexpr int TP = 16384, TT = 16512, PSTR = 3744, NLAY = 4;
constexpr int C_GLA_Q = 0, C_GLA_K = 256, C_GLA_V = 512, C_GLA_GLR = 768, C_GLA_GATE = 784;
constexpr int C_S5_U = 1040, C_S5_GATE = 1296;
constexpr int C_GDN_Q = 1552, C_GDN_A = 2320, C_GDN_B = 2324, C_GDN_GATE = 2328;
constexpr int C_RW_R = 2584, C_RW_V = 3096, C_RW_WL = 3352, C_RW_AL = 3416, C_RW_GATE = 3480;
constexpr size_t O_Y = 0;
constexpr size_t O_GLA_P = 16908288, O_S5R_P = 17432576, O_S5I_P = 17465344, O_GDN_P = 17498112, O_CONV_P = 18022400,
                 O_RW_P = 18096128, O_SH_P = 18620416, O_GLA_S = 18649088, O_S5R_S = 27037696, O_S5I_S = 27561984,
                 O_GDN_S = 28086272, O_CONV_S = 36474880, O_RW_S = 37654528, O_SH_S = 46043136;
constexpr size_t W_PROJ = 0;
constexpr size_t W_HB = W_PROJ + (size_t)TT * PSTR * 2;
constexpr size_t W_WIN = W_HB + (size_t)TT * 1024 * 2;
constexpr size_t W_WOUT = W_WIN + (size_t)3840 * 1024 * 2;
constexpr size_t W_WGLU = W_WOUT + (size_t)1024 * 1024 * 2;
constexpr size_t W_WW2 = W_WGLU + 131072;
constexpr size_t W_WA2 = W_WW2 + 32768;
constexpr size_t W_S5P = W_WA2 + 32768;
constexpr size_t W_S5E = W_S5P + 147456;
constexpr size_t W_AUX = W_S5E + 2097152;
constexpr size_t W_TILES = W_AUX + 1572864;
constexpr size_t W_BAR = W_TILES + (size_t)11 * 8192 * 1024;
constexpr size_t W_PART = W_BAR + 16384;
constexpr size_t W_END = W_PART + (size_t)4 * 128 * 1024 * 4;

constexpr int LDS_BYTES = 74752;

struct Params {
  const float* in[40];
  float* out;
  char* ws;
};

DI float bf2f(u16 h) { return __uint_as_float(((unsigned)h) << 16); }
typedef __attribute__((ext_vector_type(2))) float f32x2_t;
typedef __attribute__((ext_vector_type(2))) __bf16 bf16x2_t;
DI unsigned pk2(float a, float b) { f32x2_t v = {a, b}; bf16x2_t r = __builtin_convertvector(v, bf16x2_t); return __builtin_bit_cast(unsigned, r); }
DI u16 f2bf(float f) { return (u16)(pk2(f, f) & 0xffffu); }
DI void unpk8(uint4 a, float* o) {
  o[0] = __uint_as_float(a.x << 16); o[1] = __uint_as_float(a.x & 0xffff0000u);
  o[2] = __uint_as_float(a.y << 16); o[3] = __uint_as_float(a.y & 0xffff0000u);
  o[4] = __uint_as_float(a.z << 16); o[5] = __uint_as_float(a.z & 0xffff0000u);
  o[6] = __uint_as_float(a.w << 16); o[7] = __uint_as_float(a.w & 0xffff0000u);
}
DI void ld16(const u16* p, float* o) { unpk8(*(const uint4*)p, o); unpk8(*(const uint4*)(p + 8), o + 8); }
DI void st16(u16* p, const float* v) {
  uint4 a, b;
  a.x = pk2(v[0], v[1]); a.y = pk2(v[2], v[3]); a.z = pk2(v[4], v[5]); a.w = pk2(v[6], v[7]);
  b.x = pk2(v[8], v[9]); b.y = pk2(v[10], v[11]); b.z = pk2(v[12], v[13]); b.w = pk2(v[14], v[15]);
  *(uint4*)p = a; *(uint4*)(p + 8) = b;
}
typedef __attribute__((ext_vector_type(4))) unsigned u32x4v;
DI uint4 ntl4(const u16* p) { const u32x4v v = __builtin_nontemporal_load((const u32x4v*)p); return make_uint4(v[0], v[1], v[2], v[3]); }
#define NTL4(p) ntl4(p)
DI void ld16nt(const u16* p, float* o) { unpk8(ntl4(p), o); unpk8(ntl4(p + 8), o + 8); }
DI float sigm(float x) { return __builtin_amdgcn_rcpf(1.f + __expf(-x)); }
DI float silu(float x) { return x * sigm(x); }
DI float softplus(float x) { return fmaxf(x, 0.f) + __logf(1.f + __expf(-fabsf(x))); }
DI float ftanh(float x) { const float e = __expf(-2.f * fabsf(x)); const float r = (1.f - e) * __builtin_amdgcn_rcpf(1.f + e); return x < 0.f ? -r : r; }
DI float wsum(float v) { for (int o = 32; o; o >>= 1) v += __shfl_xor(v, o); return v; }
DI float qsum(float v) { v += __shfl_xor(v, 1); v += __shfl_xor(v, 2); return v; }

DI const float* opq(const float* p) { asm volatile("" : "+s"(p)); return p; }
DI const float* xrow(const Params& P, int layer, int r) {
  const float* xp = opq(P.in[0]); const float* xs = opq(P.in[1]); const float* xo = opq(P.out);
  if (layer == 0) return r < TP ? xp + (size_t)r * 1024 : xs + (size_t)(r - TP) * 1024;
  return xo + (size_t)r * 1024;
}

DI void tr_tile(const float* src, int N, int ld, u16* dst, int K, int k0, int n0, float* T) {
  int tid_ = threadIdx.x; asm volatile("" : "+v"(tid_));
  const int tid = tid_;
  const int kk = tid >> 4, n4 = (tid & 15) * 4;
#pragma unroll
  for (int p = 0; p < 4; ++p) {
    int k = kk + 16 * p;
    float4 v = make_float4(0.f, 0.f, 0.f, 0.f);
    if (n0 + n4 < N) v = *(const float4*)(src + (size_t)(k0 + k) * ld + n0 + n4);
    T[k * 65 + n4] = v.x; T[k * 65 + n4 + 1] = v.y; T[k * 65 + n4 + 2] = v.z; T[k * 65 + n4 + 3] = v.w;
  }
  __syncthreads();
  const int n = tid >> 2, kq = (tid & 3) * 16;
  float v[16];
#pragma unroll
  for (int j = 0; j < 16; ++j) v[j] = T[(kq + j) * 65 + n];
  st16(dst + (size_t)(n0 + n) * K + k0 + kq, v);
  __syncthreads();
}

DI void phase_norm(const Params& P, int layer, char* lds) {
  int tid_ = threadIdx.x; asm volatile("" : "+v"(tid_));
  const int tid = tid_, wave = tid >> 6, lane = tid & 63;
  u16* hb = (u16*)(P.ws + W_HB);
  const float* g = P.in[9] + layer * 1024;
  {
    int r = blockIdx.x * 4 + wave;
    float4 v[4], nv[4];
    if (r < TT) {
      const float4* x = (const float4*)xrow(P, layer, r);
#pragma unroll
      for (int i = 0; i < 4; ++i) { const f32x4 t_ = __builtin_nontemporal_load((const f32x4*)(x + lane + 64 * i)); v[i] = make_float4(t_[0], t_[1], t_[2], t_[3]); }
    }
    for (; r < TT; r += gridDim.x * 4) {
      const int rn = r + gridDim.x * 4;
      if (rn < TT) {
        const float4* xn = (const float4*)xrow(P, layer, rn);
#pragma unroll
        for (int i = 0; i < 4; ++i) { const f32x4 t_ = __builtin_nontemporal_load((const f32x4*)(xn + lane + 64 * i)); nv[i] = make_float4(t_[0], t_[1], t_[2], t_[3]); }
      }
      if (layer > 0 && r >= TP) {
        const float4* pp = (const float4*)(P.ws + W_PART) + (size_t)(r - TP) * 256;
#pragma unroll
        for (int kq = 0; kq < 4; ++kq)
#pragma unroll
          for (int i = 0; i < 4; ++i) {
            const float4 pv = pp[(size_t)kq * 128 * 256 + lane + 64 * i];
            v[i].x += pv.x; v[i].y += pv.y; v[i].z += pv.z; v[i].w += pv.w;
          }
        float4* xo = (float4*)(P.out + (size_t)r * 1024);
#pragma unroll
        for (int i = 0; i < 4; ++i) xo[lane + 64 * i] = v[i];
      }
      float ss = 0.f;
#pragma unroll
      for (int i = 0; i < 4; ++i) ss += v[i].x * v[i].x + v[i].y * v[i].y + v[i].z * v[i].z + v[i].w * v[i].w;
      ss = wsum(ss);
      const float rs = rsqrtf(ss * (1.f / 1024.f) + 1e-6f);
#pragma unroll
      for (int i = 0; i < 4; ++i) {
        float4 gg = ((const float4*)g)[lane + 64 * i];
        uint2 w; w.x = pk2(v[i].x * rs * gg.x, v[i].y * rs * gg.y); w.y = pk2(v[i].z * rs * gg.z, v[i].w * rs * gg.w);
        *(uint2*)(hb + (size_t)r * 1024 + (lane + 64 * i) * 4) = w;
      }
#pragma unroll
      for (int i = 0; i < 4; ++i) v[i] = nv[i];
    }
  }
  if (layer == 0) {
    const float4* xs4 = (const float4*)P.in[1];
    float4* xo4 = (float4*)(P.out + (size_t)TP * 1024);
    for (int e = blockIdx.x * 256 + tid; e < 128 * 256; e += gridDim.x * 256) xo4[e] = xs4[e];
  }
  float* T = (float*)lds;
  const float* win = P.in[10] + (size_t)layer * 1024 * 3736;
  const float* wout = P.in[38] + (size_t)layer * 1024 * 1024;
  const float* wglu = P.in[22] + (size_t)layer * 256 * 256;
  const float* ww2 = P.in[30] + (size_t)layer * 64 * 256;
  const float* wa2 = P.in[32] + (size_t)layer * 64 * 256;
  for (int u = blockIdx.x; u < 960 + 256 + 16 + 4 + 4; u += gridDim.x) {
    if (u < 960) tr_tile(win, 3736, 3736, (u16*)(P.ws + W_WIN), 1024, (u & 15) * 64, (u >> 4) * 64, T);
    else if (u < 1216) { int v = u - 960; tr_tile(wout, 1024, 1024, (u16*)(P.ws + W_WOUT), 1024, (v & 15) * 64, (v >> 4) * 64, T); }
    else if (u < 1232) { int v = u - 1216; tr_tile(wglu, 256, 256, (u16*)(P.ws + W_WGLU), 256, (v & 3) * 64, (v >> 2) * 64, T); }
    else if (u < 1236) { int v = u - 1232; tr_tile(ww2, 256, 256, (u16*)(P.ws + W_WW2), 64, 0, v * 64, T); }
    else { int v = u - 1236; tr_tile(wa2, 256, 256, (u16*)(P.ws + W_WA2), 64, 0, v * 64, T); }
  }
  {
    const int gsz = gridDim.x * 256;
    float* sp = (float*)(P.ws + W_S5P);
    u16* bbt = (u16*)(P.ws + W_S5P + 16384);
    u16* cmt = bbt + 16 * 128 * 16;
    for (int e = blockIdx.x * 256 + tid; e < 16384; e += gsz) {
      const int it = e >> 4, c = e & 15;
      const int gq = it >> 6, p = it & 63;
      const float lr = P.in[14][layer * 1024 + it], li = P.in[15][layer * 1024 + it];
      const float step = expf(P.in[16][layer * 16 + gq]);
      const float br = P.in[17][((size_t)layer * 1024 + it) * 16 + c], bi = P.in[18][((size_t)layer * 1024 + it) * 16 + c];
      const float cre = P.in[19][(((size_t)layer * 16 + gq) * 16 + c) * 64 + p];
      const float cim = P.in[20][(((size_t)layer * 16 + gq) * 16 + c) * 64 + p];
      const float mag = expf(lr * step);
      const float ar = mag * cosf(li * step), ai = mag * sinf(li * step);
      const float den = lr * lr + li * li;
      const float zr = ((ar - 1.f) * lr + ai * li) / den, zi = (ai * lr - (ar - 1.f) * li) / den;
      if (c == 0) {
        sp[it] = ar; sp[1024 + it] = ai;
        float pr = ar, pi = ai;
        for (int s2 = 0; s2 < 6; ++s2) { const float nr = pr * pr - pi * pi, ni = 2.f * pr * pi; pr = nr; pi = ni; }
        sp[2048 + it] = pr; sp[3072 + it] = pi;
      }
      bbt[(gq * 128 + p) * 16 + c] = f2bf(zr * br - zi * bi);
      bbt[(gq * 128 + 64 + p) * 16 + c] = f2bf(zr * bi + zi * br);
      cmt[(gq * 16 + c) * 128 + p] = f2bf(cre);
      cmt[(gq * 16 + c) * 128 + 64 + p] = f2bf(-cim);
    }
  }
}

DI void gemm_tile(const Params& P, int layer, const u16* A, const u16* Bt, int m0, int n0, int mode, int kt0, int nk, char* lds) {
  u16* As = (u16*)lds; u16* Bs = As + 128 * 72;
  int tid_ = threadIdx.x; asm volatile("" : "+v"(tid_));
  const int tid = tid_, wave = tid >> 6, lane = tid & 63, l16 = lane & 15, g4 = lane >> 4;
  const int wm = wave >> 1, wn = wave & 1;
  f32x4 acc[4][4];
#pragma unroll
  for (int i = 0; i < 4; ++i)
#pragma unroll
    for (int j = 0; j < 4; ++j) acc[i][j] = (f32x4){0.f, 0.f, 0.f, 0.f};
  uint4 ra0, ra1, ra2, ra3, rb0, rb1, rb2, rb3;
  const int lrow = tid >> 3, lc8 = (tid & 7) * 8;
  const u16* Ap = A + (size_t)(m0 + lrow) * 1024 + lc8 + kt0 * 64;
  const u16* Bp = Bt + (size_t)(n0 + lrow) * 1024 + lc8 + kt0 * 64;
#define G_LOAD(kt)                                                      \
  ra0 = *(const uint4*)(Ap + (kt) * 64); ra1 = *(const uint4*)(Ap + 32 * 1024 + (kt) * 64);           \
  ra2 = *(const uint4*)(Ap + 64 * 1024 + (kt) * 64); ra3 = *(const uint4*)(Ap + 96 * 1024 + (kt) * 64); \
  rb0 = *(const uint4*)(Bp + (kt) * 64); rb1 = *(const uint4*)(Bp + 32 * 1024 + (kt) * 64);           \
  rb2 = *(const uint4*)(Bp + 64 * 1024 + (kt) * 64); rb3 = *(const uint4*)(Bp + 96 * 1024 + (kt) * 64);
#define G_STORE(st)                                                     \
  { u16* as_ = As + (st) * 2 * 128 * 72; u16* bs_ = Bs + (st) * 2 * 128 * 72;                           \
    *(uint4*)(as_ + lrow * 72 + lc8) = ra0; *(uint4*)(as_ + (lrow + 32) * 72 + lc8) = ra1;             \
    *(uint4*)(as_ + (lrow + 64) * 72 + lc8) = ra2; *(uint4*)(as_ + (lrow + 96) * 72 + lc8) = ra3;      \
    *(uint4*)(bs_ + lrow * 72 + lc8) = rb0; *(uint4*)(bs_ + (lrow + 32) * 72 + lc8) = rb1;             \
    *(uint4*)(bs_ + (lrow + 64) * 72 + lc8) = rb2; *(uint4*)(bs_ + (lrow + 96) * 72 + lc8) = rb3; }
  G_LOAD(0);
  __syncthreads();
  G_STORE(0);
  if (nk > 1) { G_LOAD(1); }
  __syncthreads();
  for (int kt = 0; kt < nk; ++kt) {
    const int cur = kt & 1;
    const u16* as_ = As + cur * 2 * 128 * 72; const u16* bs_ = Bs + cur * 2 * 128 * 72;
#pragma unroll
    for (int ks = 0; ks < 2; ++ks) {
      bf16x8 a[4], b[4];
#pragma unroll
      for (int mt = 0; mt < 4; ++mt) a[mt] = *(const bf16x8*)(as_ + (wm * 64 + mt * 16 + l16) * 72 + ks * 32 + g4 * 8);
#pragma unroll
      for (int nt = 0; nt < 4; ++nt) b[nt] = *(const bf16x8*)(bs_ + (wn * 64 + nt * 16 + l16) * 72 + ks * 32 + g4 * 8);
#pragma unroll
      for (int mt = 0; mt < 4; ++mt)
#pragma unroll
        for (int nt = 0; nt < 4; ++nt) acc[mt][nt] = MFMA16(a[mt], b[nt], acc[mt][nt]);
    }
    if (kt + 1 < nk) {
      G_STORE(cur ^ 1);
      if (kt + 2 < nk) { G_LOAD(kt + 2); }
    }
    __syncthreads();
  }
#undef G_LOAD
#undef G_STORE
  if (mode == 0) {
    u16* proj = (u16*)(P.ws + W_PROJ);
#pragma unroll
    for (int mt = 0; mt < 4; ++mt)
#pragma unroll
      for (int nt = 0; nt < 4; ++nt) {
        const int col = n0 + wn * 64 + nt * 16 + l16;
        if (col < PSTR) {
#pragma unroll
          for (int i = 0; i < 4; ++i) {
            const int row = m0 + wm * 64 + mt * 16 + 4 * g4 + i;
            proj[(size_t)row * PSTR + col] = f2bf(acc[mt][nt][i]);
          }
        }
      }
  } else if (mode == 1) {
#pragma unroll
    for (int mt = 0; mt < 4; ++mt)
#pragma unroll
      for (int i = 0; i < 4; ++i) {
        const int row = m0 + wm * 64 + mt * 16 + 4 * g4 + i;
        const float* xr = xrow(P, layer, row);
#pragma unroll
        for (int nt = 0; nt < 4; ++nt) {
          const int col = n0 + wn * 64 + nt * 16 + l16;
          P.out[(size_t)row * 1024 + col] = xr[col] + acc[mt][nt][i];
        }
      }
  } else {
    float* part = (float*)(P.ws + W_PART) + (size_t)(kt0 >> 2) * 128 * 1024;
#pragma unroll
    for (int mt = 0; mt < 4; ++mt)
#pragma unroll
      for (int i = 0; i < 4; ++i) {
        const int row = m0 - TP + wm * 64 + mt * 16 + 4 * g4 + i;
#pragma unroll
        for (int nt = 0; nt < 4; ++nt) {
          const int col = n0 + wn * 64 + nt * 16 + l16;
          part[(size_t)row * 1024 + col] = acc[mt][nt][i];
        }
      }
  }
}

DI void gemm1_tile(const Params& P, const u16* A, const u16* Bt, int m0, int n0, char* lds) {
  int tid_ = threadIdx.x; asm volatile("" : "+v"(tid_));
  const int tid = tid_, wave = tid >> 6, lane = tid & 63, l16 = lane & 15, g4 = lane >> 4;
  const int wm = wave >> 1, wn = wave & 1;
  f32x4 acc[4][8];
#pragma unroll
  for (int i = 0; i < 4; ++i)
#pragma unroll
    for (int j = 0; j < 8; ++j) acc[i][j] = (f32x4){0.f, 0.f, 0.f, 0.f};
  uint4 ra0, ra1, rb0, rb1, rb2, rb3;
  const int lrow = tid >> 2, lc8 = (tid & 3) * 8;
  const u16* Ap = A + (size_t)(m0 + lrow) * 1024 + lc8;
  const u16* Bp = Bt + (size_t)(n0 + lrow) * 1024 + lc8;
#define H_LOAD(kt)                                                                                      \
  ra0 = *(const uint4*)(Ap + (kt) * 32); ra1 = *(const uint4*)(Ap + 64 * 1024 + (kt) * 32);             \
  rb0 = *(const uint4*)(Bp + (kt) * 32); rb1 = *(const uint4*)(Bp + 64 * 1024 + (kt) * 32);             \
  rb2 = *(const uint4*)(Bp + 128 * 1024 + (kt) * 32); rb3 = *(const uint4*)(Bp + 192 * 1024 + (kt) * 32);
#define H_STORE(st)                                                                                     \
  { u16* as_ = (u16*)(lds + (st) * 30720); u16* bs_ = as_ + 128 * 40;                                    \
    *(uint4*)(as_ + lrow * 40 + lc8) = ra0; *(uint4*)(as_ + (lrow + 64) * 40 + lc8) = ra1;              \
    *(uint4*)(bs_ + lrow * 40 + lc8) = rb0; *(uint4*)(bs_ + (lrow + 64) * 40 + lc8) = rb1;              \
    *(uint4*)(bs_ + (lrow + 128) * 40 + lc8) = rb2; *(uint4*)(bs_ + (lrow + 192) * 40 + lc8) = rb3; }
#define H_COMPUTE(st)                                                                                   \
  { const u16* as_ = (const u16*)(lds + (st) * 30720); const u16* bs_ = as_ + 128 * 40;                  \
    bf16x8 a[4], b[8];                                                                                  \
    _Pragma("unroll") for (int mt = 0; mt < 4; ++mt) a[mt] = *(const bf16x8*)(as_ + (wm * 64 + mt * 16 + l16) * 40 + g4 * 8);   \
    _Pragma("unroll") for (int nt = 0; nt < 8; ++nt) b[nt] = *(const bf16x8*)(bs_ + (wn * 128 + nt * 16 + l16) * 40 + g4 * 8);  \
    _Pragma("unroll") for (int mt = 0; mt < 4; ++mt) _Pragma("unroll") for (int nt = 0; nt < 8; ++nt)     \
      acc[mt][nt] = MFMA16(a[mt], b[nt], acc[mt][nt]); }
  H_LOAD(0);
  __syncthreads();
  H_STORE(0);
  H_LOAD(1);
  __syncthreads();
  for (int kt = 0; kt < 32; kt += 2) {
    H_COMPUTE(0);
    H_STORE(1);
    if (kt + 2 < 32) { H_LOAD(kt + 2); }
    __syncthreads();
    H_COMPUTE(1);
    if (kt + 2 < 32) {
      H_STORE(0);
      H_LOAD(kt + 3);
    }
    __syncthreads();
  }
#undef H_LOAD
#undef H_STORE
#undef H_COMPUTE
  u16* proj = (u16*)(P.ws + W_PROJ);
#pragma unroll
  for (int mt = 0; mt < 4; ++mt)
#pragma unroll
    for (int nt = 0; nt < 8; ++nt) {
      const int col = n0 + wn * 128 + nt * 16 + l16;
      if (col < PSTR) {
#pragma unroll
        for (int i = 0; i < 4; ++i) {
          const int row = m0 + wm * 64 + mt * 16 + 4 * g4 + i;
          proj[(size_t)row * PSTR + col] = f2bf(acc[mt][nt][i]);
        }
      }
    }
}

DI void phase_gemm1(const Params& P, int layer, char* lds) {
  const u16* A = (const u16*)(P.ws + W_HB);
  const u16* Bt = (const u16*)(P.ws + W_WIN);
  const int x = blockIdx.x & 7, j = blockIdx.x >> 3, nloc = gridDim.x >> 3;
  for (int t = j; t < 240; t += nloc) {
    const int mg = t / 120, rem = t - mg * 120;
    gemm1_tile(P, A, Bt, (x * 16 + mg * 8 + (rem & 7)) * 128, (rem >> 3) * 256, lds);
  }
  const int base = 240 % nloc;
  for (int e = 0; e < 2; ++e) {
    const int n = x + 8 * e;
    if (n < 15 && j == (base + e) % nloc) gemm1_tile(P, A, Bt, TP, n * 256, lds);
  }
}
DI void phase_gemm2(const Params& P, int layer, char* lds) {
  const u16* A = (const u16*)(P.ws + W_HB);
  const u16* Bt = (const u16*)(P.ws + W_WOUT);
  const int x = blockIdx.x & 7, j = blockIdx.x >> 3, nloc = gridDim.x >> 3;
  for (int t = j; t < 128; t += nloc) gemm_tile(P, layer, A, Bt, (x * 16 + (t >> 3)) * 128, (t & 7) * 128, 1, 0, 16, lds);
  const int base = 128 % nloc;
  for (int e = 0; e < 4; ++e) {
    const int v = x * 4 + e;
    if (j == (base + e) % nloc) gemm_tile(P, layer, A, Bt, TP, (v & 7) * 128, 2, (v >> 3) * 4, 4, lds);
  }
}

DI void epi_row(const Params& P, int layer, int m, int h, int tok, int q, const float* o, const u16* prevrow,
                const float* prevf, float bonus, bool active) {
  float s = 0.f, ss = 0.f;
#pragma unroll
  for (int j = 0; j < 16; ++j) { s += o[j]; ss += o[j] * o[j]; }
  s = qsum(s); ss = qsum(ss);
  if (!active) return;
  const u16* prow = (const u16*)(P.ws + W_PROJ) + (size_t)tok * PSTR;
  const int col0 = h * 64 + 16 * q;
  const int gcol = (m == 0 ? C_GLA_GATE : (m == 1 ? C_GDN_GATE : C_RW_GATE)) + col0;
  u16* mixed = (u16*)(P.ws + W_HB) + (size_t)tok * 1024 + (m == 0 ? 0 : (m == 1 ? 512 : 768)) + col0;
  const float mu = s * (1.f / 64.f);
  const float r = (m < 2) ? rsqrtf(ss * (1.f / 64.f) + 1e-6f) : rsqrtf(fmaxf(ss * (1.f / 64.f) - mu * mu, 0.f) + 64e-5f);
  const float* gn0 = opq(P.in[13]); const float* gn1 = opq(P.in[27]);
  const float* gn = (m == 0 ? gn0 : gn1) + layer * 64 + 16 * q;
  const float* lng = P.in[36] + layer * 256 + col0;
  const float* lnb = P.in[37] + layer * 256 + col0;
  const float* muv = P.in[28] + layer * 896 + 512 + col0;
#pragma unroll
  for (int c4 = 0; c4 < 4; ++c4) {
    float outv[4];
    const uint2 gw = *(const uint2*)(prow + gcol + 4 * c4);
    float gate[4];
    gate[0] = __uint_as_float(gw.x << 16); gate[1] = __uint_as_float(gw.x & 0xffff0000u);
    gate[2] = __uint_as_float(gw.y << 16); gate[3] = __uint_as_float(gw.y & 0xffff0000u);
    if (m < 2) {
#pragma unroll
      for (int j = 0; j < 4; ++j) outv[j] = o[4 * c4 + j] * r * gn[4 * c4 + j] * silu(gate[j]);
    } else {
      const uint2 xw = *(const uint2*)(prow + C_RW_V + col0 + 4 * c4);
      float xv[4], pv[4];
      xv[0] = __uint_as_float(xw.x << 16); xv[1] = __uint_as_float(xw.x & 0xffff0000u);
      xv[2] = __uint_as_float(xw.y << 16); xv[3] = __uint_as_float(xw.y & 0xffff0000u);
      if (prevf) {
#pragma unroll
        for (int j = 0; j < 4; ++j) pv[j] = prevf[512 + col0 + 4 * c4 + j];
      } else if (prevrow) {
        const uint2 pw = *(const uint2*)(prevrow + C_RW_V + col0 + 4 * c4);
        pv[0] = __uint_as_float(pw.x << 16); pv[1] = __uint_as_float(pw.x & 0xffff0000u);
        pv[2] = __uint_as_float(pw.y << 16); pv[3] = __uint_as_float(pw.y & 0xffff0000u);
      } else {
#pragma unroll
        for (int j = 0; j < 4; ++j) pv[j] = 0.f;
      }
#pragma unroll
      for (int j = 0; j < 4; ++j) {
        const float vs = xv[j] + (pv[j] - xv[j]) * muv[4 * c4 + j];
        outv[j] = ((o[4 * c4 + j] - mu) * r * lng[4 * c4 + j] + lnb[4 * c4 + j] + bonus * vs) * silu(gate[j]);
      }
    }
    uint2 w; w.x = pk2(outv[0], outv[1]); w.y = pk2(outv[2], outv[3]);
    *(uint2*)(mixed + 4 * c4) = w;
    __builtin_amdgcn_sched_barrier(0);
  }
}

DI int tix(int r, int c) { return r * 64 + (c ^ ((r & 7) << 3)); }
DI void st16t(u16* tile, int r, int c, const float* v) {
  uint4 a, b;
  a.x = pk2(v[0], v[1]); a.y = pk2(v[2], v[3]); a.z = pk2(v[4], v[5]); a.w = pk2(v[6], v[7]);
  b.x = pk2(v[8], v[9]); b.y = pk2(v[10], v[11]); b.z = pk2(v[12], v[13]); b.w = pk2(v[14], v[15]);
  *(uint4*)(tile + tix(r, c)) = a; *(uint4*)(tile + tix(r, c + 8)) = b;
}
DI void mm64(f32x4* acc, const u16* A, const u16* Bt, int wave, int l16, int g4) {
#pragma unroll
  for (int ks = 0; ks < 2; ++ks) {
    bf16x8 a = *(const bf16x8*)(A + tix(wave * 16 + l16, ks * 32 + g4 * 8));
#pragma unroll
    for (int nt = 0; nt < 4; ++nt) {
      bf16x8 b = *(const bf16x8*)(Bt + tix(nt * 16 + l16, ks * 32 + g4 * 8));
      acc[nt] = MFMA16(a, b, acc[nt]);
    }
  }
}
DI void zero4(f32x4* a) {
#pragma unroll
  for (int i = 0; i < 4; ++i) a[i] = (f32x4){0.f, 0.f, 0.f, 0.f};
}

struct RowCtx {
  const u16* prow;
  int npast;
  const float* cst;
  const float* sst;
  bool valid;
};

DI void mix_unit(const Params& P, int layer, int m, int kind, int bs, int h, int c, char* lds) {
  int tid_ = threadIdx.x; asm volatile("" : "+v"(tid_));
  const int tid = tid_, wave = tid >> 6, lane = tid & 63, l16 = lane & 15, g4 = lane >> 4;
  const int t = tid >> 2, q = tid & 3;
  u16* R0 = (u16*)lds; u16* R1 = R0 + 4096; u16* R2 = R0 + 2 * 4096; u16* R3 = R0 + 3 * 4096;
  u16* R4 = R0 + 4 * 4096; u16* R5 = R0 + 5 * 4096; u16* R6 = R0 + 6 * 4096;
  float* F0 = (float*)(lds + 57344);
  float* SM = (float*)(lds + 73728);
  const u16* proj = (const u16*)(P.ws + W_PROJ);

  RowCtx R;
  int tok;
  if (kind == 0) {
    tok = bs * 2048 + c * 64 + t;
    R.prow = proj + (size_t)tok * PSTR; R.npast = c * 64 + t; R.cst = nullptr; R.sst = nullptr; R.valid = true;
  } else {
    tok = TP + bs;
    R.prow = proj + (size_t)tok * PSTR; R.npast = 0;
    R.cst = P.in[6] + ((size_t)layer * 128 + bs) * 2304;
    R.sst = P.in[8] + ((size_t)layer * 128 + bs) * 896;
    R.valid = (t == 0);
  }
  float al[16], be[16], kr[16], qv[16], vv[16], ld[16];
  float sst16[16];
#pragma unroll
  for (int i = 0; i < 16; ++i) sst16[i] = 0.f;
  if (kind == 1) {
    const int kq = wave, v = lane;
    const size_t sbase = ((size_t)(layer * 128 + bs) * 4 + h) * 4096;
    const float* si0 = opq(P.in[2]); const float* si1 = opq(P.in[5]); const float* si2 = opq(P.in[7]);
    const float* sin = (m == 0 ? si0 : (m == 1 ? si1 : si2)) + sbase;
    if (m == 2) {
#pragma unroll
      for (int i = 0; i < 4; ++i) {
        float4 x = *(const float4*)(sin + v * 64 + 16 * kq + 4 * i);
        sst16[4 * i] = x.x; sst16[4 * i + 1] = x.y; sst16[4 * i + 2] = x.z; sst16[4 * i + 3] = x.w;
      }
    } else {
#pragma unroll
      for (int i = 0; i < 16; ++i) sst16[i] = sin[(16 * kq + i) * 64 + v];
    }
  }
  float gtok = 0.f, bonus = 0.f;
#pragma unroll
  for (int j = 0; j < 16; ++j) { al[j] = 0.f; be[j] = 0.f; kr[j] = 0.f; qv[j] = 0.f; vv[j] = 0.f; ld[j] = 0.f; }
  const int d0 = h * 64 + 16 * q;

  if (m == 0) {
    if (R.valid) {
      float kk[16], glr[16];
      ld16nt(R.prow + C_GLA_Q + d0, qv); ld16nt(R.prow + C_GLA_K + d0, kk); ld16nt(R.prow + C_GLA_V + d0, vv);
      ld16(R.prow + C_GLA_GLR, glr);
      float x[16];
      const float* bg = P.in[12] + layer * 256 + d0;
      const float* wg = P.in[11] + (size_t)layer * 16 * 256 + d0;
#pragma unroll
      for (int j = 0; j < 16; ++j) x[j] = bg[j];
#pragma unroll
      for (int r = 0; r < 16; ++r) {
#pragma unroll
        for (int j = 0; j < 16; ++j) x[j] += glr[r] * wg[r * 256 + j];
        if ((r & 7) == 7) __builtin_amdgcn_sched_barrier(0);
      }
#pragma unroll
      for (int j = 0; j < 16; ++j) { ld[j] = -softplus(-x[j]) * (1.f / 16.f); kr[j] = kk[j]; qv[j] *= 0.125f; }
    }
  } else if (m == 1) {
    float a_raw = 0.f, b_raw = 0.f;
    float* cwL = (float*)R6;
    for (int e = tid; e < 768; e += 256) {
      const int part = e >> 8, tap = (e >> 6) & 3, d = e & 63;
      cwL[e] = P.in[24][(size_t)layer * 3072 + tap * 768 + part * 256 + h * 64 + d];
    }
    __syncthreads();
    if (R.valid) {
      uint4 xr[3][4][2];
      if (!R.cst) {
#pragma unroll
        for (int part = 0; part < 3; ++part)
#pragma unroll
          for (int jj = 0; jj < 4; ++jj) {
            const bool ok = R.npast >= jj;
            const u16* pp = R.prow - (size_t)(ok ? jj : 0) * PSTR + C_GDN_Q + part * 256 + d0;
            uint4 v0 = *(const uint4*)pp, v1 = *(const uint4*)(pp + 8);
            if (!ok) { v0 = make_uint4(0, 0, 0, 0); v1 = v0; }
            xr[part][jj][0] = v0; xr[part][jj][1] = v1;
          }
      }
      a_raw = bf2f(R.prow[C_GDN_A + h]); b_raw = bf2f(R.prow[C_GDN_B + h]);
#pragma unroll
      for (int part = 0; part < 3; ++part) {
        const int colrel = part * 256 + d0;
        const float* cw = cwL + part * 256 + 16 * q;
        float acc[16];
        if (R.cst) {
          float x[16];
          ld16(R.prow + C_GDN_Q + colrel, x);
#pragma unroll
          for (int j = 0; j < 16; ++j) acc[j] = x[j] * cw[3 * 64 + j];
#pragma unroll
          for (int jj = 1; jj <= 3; ++jj) {
            const float* sp_ = R.cst + (3 - jj) * 768 + colrel;
#pragma unroll
            for (int j = 0; j < 16; ++j) acc[j] += sp_[j] * cw[(3 - jj) * 64 + j];
          }
        } else {
#pragma unroll
          for (int j = 0; j < 16; ++j) acc[j] = 0.f;
#pragma unroll
          for (int jj = 0; jj < 4; ++jj) {
            float x[16];
            unpk8(xr[part][jj][0], x); unpk8(xr[part][jj][1], x + 8);
#pragma unroll
            for (int j = 0; j < 16; ++j) acc[j] += x[j] * cw[(3 - jj) * 64 + j];
          }
        }
        __builtin_amdgcn_sched_barrier(0);
#pragma unroll
        for (int j = 0; j < 16; ++j) {
          const float sv = silu(acc[j]);
          if (part == 0) qv[j] = sv; else if (part == 1) al[j] = sv; else vv[j] = sv;
        }
      }
      a_raw = bf2f(R.prow[C_GDN_A + h]); b_raw = bf2f(R.prow[C_GDN_B + h]);
    }
    float sq = 0.f, sk = 0.f;
#pragma unroll
    for (int j = 0; j < 16; ++j) { sq += qv[j] * qv[j]; sk += al[j] * al[j]; }
    sq = qsum(sq); sk = qsum(sk);
    if (R.valid) {
      const float rq = rsqrtf(sq + 1e-6f) * 0.125f, rk = rsqrtf(sk + 1e-6f);
      const float gg = -__expf(P.in[25][layer * 4 + h]) * softplus(a_raw + P.in[26][layer * 4 + h]);
      const float beta = sigm(b_raw);
      const float eg = __expf(gg);
      gtok = gg;
#pragma unroll
      for (int j = 0; j < 16; ++j) {
        const float k = al[j] * rk;
        al[j] = k; be[j] = -eg * beta * k; kr[j] = beta * k; qv[j] *= rq;
      }
    }
  } else {
    const float* mu = P.in[28] + layer * 896;
    uint4 hx[3][2], hp[3][2];
#pragma unroll
    for (int part = 0; part < 3; ++part) {
      const bool okp = R.valid && !R.sst && R.npast >= 1;
      const u16* pc = R.prow + C_RW_R + part * 256 + d0;
      const u16* pq = pc - (okp ? PSTR : 0);
      uint4 c0 = *(const uint4*)pc, c1 = *(const uint4*)(pc + 8), p0 = *(const uint4*)pq, p1 = *(const uint4*)(pq + 8);
      if (!okp) { p0 = make_uint4(0, 0, 0, 0); p1 = p0; }
      hx[part][0] = c0; hx[part][1] = c1; hp[part][0] = p0; hp[part][1] = p1;
    }
    {
      float tw[16], ta[16];
#pragma unroll
      for (int j = 0; j < 16; ++j) { tw[j] = 0.f; ta[j] = 0.f; }
      if (R.valid) {
#pragma unroll
        for (int part = 3; part < 5; ++part) {
          const int colrel = (part == 3 ? 768 + 16 * q : 832 + 16 * q);
          float x[16], pv[16];
          ld16(R.prow + C_RW_R + colrel, x);
          if (R.sst) {
#pragma unroll
            for (int j = 0; j < 16; ++j) pv[j] = R.sst[colrel + j];
          } else if (R.npast >= 1) ld16(R.prow - PSTR + C_RW_R + colrel, pv);
          else {
#pragma unroll
            for (int j = 0; j < 16; ++j) pv[j] = 0.f;
          }
#pragma unroll
          for (int j = 0; j < 16; ++j) {
            const float xs = x[j] + (pv[j] - x[j]) * mu[colrel + j];
            if (part == 3) tw[j] = ftanh(xs); else ta[j] = xs;
          }
        }
      }
      st16t(R0, t, 16 * q, tw);
      st16t(R1, t, 16 * q, ta);
    }
    {
      const u16* w2 = (const u16*)(P.ws + W_WW2) + (size_t)(h * 64 + t) * 64 + 16 * q;
      const u16* a2 = (const u16*)(P.ws + W_WA2) + (size_t)(h * 64 + t) * 64 + 16 * q;
      *(uint4*)(R2 + tix(t, 16 * q)) = *(const uint4*)w2; *(uint4*)(R2 + tix(t, 16 * q + 8)) = *(const uint4*)(w2 + 8);
      *(uint4*)(R3 + tix(t, 16 * q)) = *(const uint4*)a2; *(uint4*)(R3 + tix(t, 16 * q + 8)) = *(const uint4*)(a2 + 8);
    }
    __syncthreads();
    {
      f32x4 aw[4], aa[4];
      zero4(aw); zero4(aa);
      mm64(aw, R0, R2, wave, l16, g4);
      mm64(aa, R1, R3, wave, l16, g4);
      float* FA = (float*)R4;
#pragma unroll
      for (int nt = 0; nt < 4; ++nt)
#pragma unroll
        for (int i = 0; i < 4; ++i) {
          const int row = wave * 16 + 4 * g4 + i, col = nt * 16 + l16;
          F0[row * 64 + col] = aw[nt][i]; FA[row * 64 + col] = aa[nt][i];
        }
    }
    __syncthreads();
    float av[16];
    {
      const float* FA = (const float*)R4;
      const float* w0 = P.in[29] + layer * 256 + d0;
      const float* a0 = P.in[31] + layer * 256 + d0;
#pragma unroll
      for (int j = 0; j < 16; ++j) {
        const float wraw = -softplus(-(w0[j] + F0[t * 64 + 16 * q + j])) - 0.5f;
        ld[j] = -__expf(wraw);
        av[j] = sigm(a0[j] + FA[t * 64 + 16 * q + j]);
      }
    }
    __syncthreads();
    float skk = 0.f, sb = 0.f;
    if (R.valid) {
#pragma unroll
      for (int part = 0; part < 3; ++part) {
        const int colrel = part * 256 + d0;
        float x[16], pv[16];
        unpk8(hx[part][0], x); unpk8(hx[part][1], x + 8);
        if (R.sst) {
#pragma unroll
          for (int j = 0; j < 16; ++j) pv[j] = R.sst[colrel + j];
        } else { unpk8(hp[part][0], pv); unpk8(hp[part][1], pv + 8); }
#pragma unroll
        for (int j = 0; j < 16; ++j) {
          const float xs = x[j] + (pv[j] - x[j]) * mu[colrel + j];
          if (part == 0) qv[j] = xs; else if (part == 1) kr[j] = xs; else vv[j] = xs;
        }
      }
      const float* kkw = P.in[33] + layer * 256 + d0;
      const float* kaw = P.in[34] + layer * 256 + d0;
      const float* rkw = P.in[35] + layer * 256 + d0;
#pragma unroll
      for (int j = 0; j < 16; ++j) {
        al[j] = kr[j] * kkw[j];
        skk += al[j] * al[j];
        kr[j] = kr[j] * (1.f + (av[j] - 1.f) * kaw[j]);
        sb += qv[j] * kr[j] * rkw[j];
      }
    }
    skk = qsum(skk); sb = qsum(sb);
    if (R.valid) {
      const float rn = rsqrtf(skk + 1e-6f);
      bonus = sb;
#pragma unroll
      for (int j = 0; j < 16; ++j) { al[j] *= rn; be[j] = -(al[j] * av[j]); }
    } else {
#pragma unroll
      for (int j = 0; j < 16; ++j) ld[j] = 0.f;
    }
  }

  const bool delta = (m != 0), modeS = (m == 1);

  if (kind == 1) {
    float* vec = F0;
    float* red = F0 + 512;
    float* red2 = F0 + 768;
    float* Ov = F0 + 1024;
    if (t == 0) {
#pragma unroll
      for (int j = 0; j < 16; ++j) {
        const int d = 16 * q + j;
        vec[d] = al[j]; vec[64 + d] = be[j]; vec[128 + d] = kr[j]; vec[192 + d] = qv[j]; vec[256 + d] = vv[j];
        vec[320 + d] = modeS ? __expf(gtok) : __expf(ld[j]);
      }
    }
    __syncthreads();
    const int kq = wave, v = lane;
    const size_t sbase = ((size_t)(layer * 128 + bs) * 4 + h) * 4096;
    float* sout = P.out + (m == 0 ? O_GLA_S : (m == 1 ? O_GDN_S : O_RW_S)) + sbase;
    float s[16];
#pragma unroll
    for (int i = 0; i < 16; ++i) s[i] = sst16[i];
    float zp = 0.f;
#pragma unroll
    for (int i = 0; i < 16; ++i) zp += vec[16 * kq + i] * s[i];
    red[kq * 64 + v] = zp;
    __syncthreads();
    const float z = red[v] + red[64 + v] + red[128 + v] + red[192 + v];
    const float vval = vec[256 + v];
    float op = 0.f;
#pragma unroll
    for (int i = 0; i < 16; ++i) {
      const int k = 16 * kq + i;
      s[i] = vec[320 + k] * s[i] + vec[64 + k] * z + vec[128 + k] * vval;
      op += vec[192 + k] * s[i];
    }
    red2[kq * 64 + v] = op;
    if (m == 2) {
#pragma unroll
      for (int i = 0; i < 4; ++i)
        *(float4*)(sout + v * 64 + 16 * kq + 4 * i) = make_float4(s[4 * i], s[4 * i + 1], s[4 * i + 2], s[4 * i + 3]);
    } else {
#pragma unroll
      for (int i = 0; i < 16; ++i) sout[(16 * kq + i) * 64 + v] = s[i];
    }
    __syncthreads();
    if (tid < 64) Ov[tid] = red2[tid] + red2[64 + tid] + red2[128 + tid] + red2[192 + tid];
    __syncthreads();
    float o[16];
#pragma unroll
    for (int j = 0; j < 16; ++j) o[j] = Ov[16 * q + j];
    epi_row(P, layer, m, h, tok, q, o, nullptr, R.sst, bonus, t == 0);
    if (h == 0 && m == 1) {
      float* co = P.out + O_CONV_S + ((size_t)layer * 128 + bs) * 2304;
      for (int e = tid; e < 2304; e += 256) {
        const int rrow = e / 768, cc = e % 768;
        co[e] = rrow < 2 ? R.cst[(rrow + 1) * 768 + cc] : bf2f(R.prow[C_GDN_Q + cc]);
      }
    }
    if (h == 0 && m == 2) {
      float* so = P.out + O_SH_S + ((size_t)layer * 128 + bs) * 896;
      for (int e = tid; e < 896; e += 256) so[e] = bf2f(R.prow[C_RW_R + e]);
    }
    __syncthreads();
    return;
  }

  const int u1 = (bs * 4 + h) * 32 + c;
  u16* tb = (u16*)(P.ws + W_TILES) + (size_t)(m == 0 ? u1 * 3 : 3072 + (m - 1) * 4096 + u1 * 4) * 4096;
  float* aux = (float*)(P.ws + W_AUX) + (size_t)(m * 1024 + u1) * 128;
  unsigned khat[8], bhat[8];
  float rowR = 1.f;
  {
    float bh16[16];
    if (!modeS) {
#pragma unroll
      for (int j = 0; j < 16; ++j) F0[t * 64 + 16 * q + j] = ld[j];
      __syncthreads();
      {
        const int d = tid & 63, seg = tid >> 6;
        float sacc = 0.f;
        for (int tt = 0; tt < 16; ++tt) { sacc += F0[(seg * 16 + tt) * 64 + d]; F0[(seg * 16 + tt) * 64 + d] = sacc; }
        SM[seg * 64 + d] = sacc;
      }
      __syncthreads();
      const int seg = t >> 4;
#pragma unroll
      for (int j = 0; j < 16; ++j) {
        const int d = 16 * q + j;
        const float s0 = SM[d], s1 = SM[64 + d], s2 = SM[128 + d], s3 = SM[192 + d];
        float off = 0.f;
        if (seg > 0) off += s0;
        if (seg > 1) off += s1;
        if (seg > 2) off += s2;
        const float cum = F0[t * 64 + d] + off;
        const float cC = s0 + s1 + s2 + s3;
        const float e1 = __expf(cum - ld[j]), e2 = __expf(-cum), e3 = __expf(cum), e4 = __expf(cC - cum);
        if (t == 0) aux[d] = __expf(cC);
        ld[j] = kr[j] * e4; bh16[j] = be[j] * e4;
        al[j] *= e1; be[j] *= e2; kr[j] *= e2; qv[j] *= e3;
        if ((j & 3) == 3) __builtin_amdgcn_sched_barrier(0);
      }
      __syncthreads();
    } else {
      if (q == 0) SM[t] = gtok;
      __syncthreads();
      float gc = 0.f, gall = 0.f;
      for (int j = 0; j < 64; ++j) { const float x = SM[j]; gall += x; if (j <= t) gc += x; }
      __syncthreads();
      if (q == 0) { SM[64 + t] = gc; SM[128 + t] = gc - gtok; }
      const float ehs = __expf(gall - gc);
      rowR = __expf(gc);
#pragma unroll
      for (int j = 0; j < 16; ++j) { ld[j] = kr[j] * ehs; bh16[j] = be[j] * ehs; }
      if (t == 0) {
        const float rsx = __expf(gall);
#pragma unroll
        for (int j = 0; j < 16; ++j) aux[16 * q + j] = rsx;
      }
    }
#pragma unroll
    for (int j = 0; j < 8; ++j) { khat[j] = pk2(ld[2 * j], ld[2 * j + 1]); bhat[j] = pk2(bh16[2 * j], bh16[2 * j + 1]); }
  }
  if (m == 2 && q == 0) aux[64 + t] = bonus;
  st16t(R3, t, 16 * q, qv);
  {
    float tmp[16];
#pragma unroll
    for (int j = 0; j < 16; ++j) tmp[j] = qv[j] * rowR;
    st16(tb + t * 64 + 16 * q, tmp);
  }
  st16t(R2, t, 16 * q, kr);
  if (delta) { st16t(R0, t, 16 * q, al); st16t(R1, t, 16 * q, be); }
  __syncthreads();
  const float* gcA = SM + 64;
  const float* gxA = SM + 128;
  f32x4 acc[4];
  zero4(acc); mm64(acc, R3, R2, wave, l16, g4);
#pragma unroll
  for (int nt = 0; nt < 4; ++nt)
#pragma unroll
    for (int i = 0; i < 4; ++i) {
      const int row = wave * 16 + 4 * g4 + i, col = nt * 16 + l16;
      float v = acc[nt][i];
      if (modeS) v *= __expf(fminf(gcA[row] - gcA[col], 0.f));
      R6[tix(row, col)] = f2bf(col <= row ? v : 0.f);
    }
  if (delta) {
    zero4(acc); mm64(acc, R0, R1, wave, l16, g4);
#pragma unroll
    for (int nt = 0; nt < 4; ++nt)
#pragma unroll
      for (int i = 0; i < 4; ++i) {
        const int row = wave * 16 + 4 * g4 + i, col = nt * 16 + l16;
        float v = acc[nt][i];
        if (modeS) v *= __expf(fminf(gxA[row] - gcA[col], 0.f));
        F0[col * 64 + row] = col < row ? -v : 0.f;
      }
    zero4(acc); mm64(acc, R0, R2, wave, l16, g4);
#pragma unroll
    for (int nt = 0; nt < 4; ++nt)
#pragma unroll
      for (int i = 0; i < 4; ++i) {
        const int row = wave * 16 + 4 * g4 + i, col = nt * 16 + l16;
        float v = acc[nt][i];
        if (modeS) v *= __expf(fminf(gxA[row] - gcA[col], 0.f));
        R4[tix(row, col)] = f2bf(col < row ? v : 0.f);
      }
    zero4(acc); mm64(acc, R3, R1, wave, l16, g4);
#pragma unroll
    for (int nt = 0; nt < 4; ++nt)
#pragma unroll
      for (int i = 0; i < 4; ++i) {
        const int row = wave * 16 + 4 * g4 + i, col = nt * 16 + l16;
        float v = acc[nt][i];
        if (modeS) v *= __expf(fminf(gcA[row] - gcA[col], 0.f));
        R5[tix(row, col)] = f2bf(col <= row ? v : 0.f);
      }
  }
  __syncthreads();
#pragma unroll
  for (int j = 0; j < 16; ++j) {
    R1[tix(16 * q + j, t)] = f2bf(vv[j]);
    const unsigned w = khat[j >> 1];
    R2[tix(16 * q + j, t)] = (u16)((j & 1) ? (w >> 16) : (w & 0xffffu));
  }
  __syncthreads();
  f32x4 p1[4], p2[4];
  zero4(p1); mm64(p1, R6, R1, wave, l16, g4);
  zero4(p2); mm64(p2, R2, R1, wave, l16, g4);
  if (delta) {
    zero4(acc); mm64(acc, R4, R1, wave, l16, g4);
    __syncthreads();
#pragma unroll
    for (int nt = 0; nt < 4; ++nt)
#pragma unroll
      for (int i = 0; i < 4; ++i) R4[tix(wave * 16 + 4 * g4 + i, nt * 16 + l16)] = f2bf(acc[nt][i]);
#pragma unroll
    for (int j = 0; j < 16; ++j) {
      const unsigned w = bhat[j >> 1];
      R2[tix(16 * q + j, t)] = (u16)((j & 1) ? (w >> 16) : (w & 0xffffu));
    }
    __syncthreads();
    {
      const int colx = tid >> 1, hf = tid & 1;
      const u16* rhs = colx < 64 ? R4 : R0;
      u16* xt = colx < 64 ? R3 : R6;
      const int cc = colx & 63;
      const bool scl = modeS && colx >= 64;
#pragma unroll 1
      for (int ib = 0; ib < 4; ++ib) {
        float sx[16];
#pragma unroll
        for (int r = 0; r < 16; ++r) {
          float x = bf2f(rhs[tix(16 * ib + r, cc)]);
          if (scl) x *= __expf(gxA[16 * ib + r]);
          sx[r] = hf ? 0.f : x;
        }
#pragma unroll 1
        for (int j = 8 * hf; j < 16 * ib; j += 16) {
          float xv[8];
          unpk8(*(const uint4*)(xt + tix(cc, j)), xv);
#pragma unroll
          for (int jj = 0; jj < 8; ++jj) {
            const float4* lt = (const float4*)(F0 + (j + jj) * 64 + 16 * ib);
#pragma unroll
            for (int r4 = 0; r4 < 4; ++r4) {
              const float4 l4 = lt[r4];
              sx[4 * r4] -= l4.x * xv[jj]; sx[4 * r4 + 1] -= l4.y * xv[jj];
              sx[4 * r4 + 2] -= l4.z * xv[jj]; sx[4 * r4 + 3] -= l4.w * xv[jj];
            }
          }
        }
#pragma unroll
        for (int r = 0; r < 16; ++r) sx[r] += __shfl_xor(sx[r], 1);
#pragma unroll
        for (int r2 = 0; r2 < 15; ++r2) {
          const float* lt = F0 + (16 * ib + r2) * 64 + 16 * ib;
#pragma unroll
          for (int r = r2 + 1; r < 16; ++r) sx[r] -= lt[r] * sx[r2];
        }
        if (hf == 0) st16t(xt, cc, 16 * ib, sx);
      }
    }
    __syncthreads();
    zero4(acc); mm64(acc, R5, R6, wave, l16, g4);
#pragma unroll
    for (int nt = 0; nt < 4; ++nt)
#pragma unroll
      for (int i = 0; i < 4; ++i) {
        const int row = wave * 16 + 4 * g4 + i, col = nt * 16 + l16;
        tb[row * 64 + col] = f2bf(acc[nt][i] + bf2f(tb[row * 64 + col]));
      }
    mm64(p1, R5, R3, wave, l16, g4);
    mm64(p2, R2, R3, wave, l16, g4);
    zero4(acc); mm64(acc, R2, R6, wave, l16, g4);
#pragma unroll
    for (int nt = 0; nt < 4; ++nt)
#pragma unroll
      for (int i = 0; i < 4; ++i) tb[12288 + (wave * 16 + 4 * g4 + i) * 64 + nt * 16 + l16] = f2bf(acc[nt][i]);
  }
#pragma unroll
  for (int nt = 0; nt < 4; ++nt)
#pragma unroll
    for (int i = 0; i < 4; ++i) {
      tb[4096 + (wave * 16 + 4 * g4 + i) * 64 + nt * 16 + l16] = f2bf(p1[nt][i]);
      tb[8192 + (wave * 16 + 4 * g4 + i) * 64 + nt * 16 + l16] = f2bf(p2[nt][i]);
    }
  if (c == 31 && h == 0 && m == 1) {
    float* co = P.out + O_CONV_P + ((size_t)layer * 8 + bs) * 2304;
    for (int e = tid; e < 2304; e += 256) {
      const int rrow = e / 768, cc = e % 768;
      co[e] = bf2f(proj[(size_t)(bs * 2048 + 2045 + rrow) * PSTR + C_GDN_Q + cc]);
    }
  }
  if (c == 31 && h == 0 && m == 2) {
    float* so = P.out + O_SH_P + ((size_t)layer * 8 + bs) * 896;
    for (int e = tid; e < 896; e += 256) so[e] = bf2f(proj[(size_t)(bs * 2048 + 2047) * PSTR + C_RW_R + e]);
  }
  __syncthreads();
}

DI void m2_unit(const Params& P, int layer, int m, int b, int h, char* lds) {
  int tid_ = threadIdx.x; asm volatile("" : "+v"(tid_));
  const int tid = tid_, wv = tid >> 6, lane = tid & 63, l16 = lane & 15, g4 = lane >> 4;
  u16* QdT = (u16*)lds; u16* OlT = QdT + 4608; u16* dST = QdT + 2 * 4608; u16* McT = QdT + 3 * 4608;
  float* Ot = (float*)(lds + 36864);
  float* rsA = (float*)(lds + 36864 + 16640);
  const int u0 = (b * 4 + h) * 32;
  const u16* proj = (const u16*)(P.ws + W_PROJ);
  const int lrow = tid >> 3, lc8 = (tid & 7) * 8;
  f32x4 S[4];
  zero4(S);
  uint4 rq0, rq1, ro0, ro1, rd0, rd1, rm0, rm1;
  float rrs = 0.f;
  rm0 = make_uint4(0, 0, 0, 0); rm1 = rm0;
#define M2_GLOAD(cc)                                                                                                  \
  {                                                                                                                   \
    const int u1 = u0 + (cc);                                                                                         \
    const u16* tb = (const u16*)(P.ws + W_TILES) + (size_t)(m == 0 ? u1 * 3 : 3072 + (m - 1) * 4096 + u1 * 4) * 4096 + lrow * 64 + lc8;  \
    rq0 = NTL4(tb); rq1 = NTL4(tb + 2048);                                                                            \
    ro0 = NTL4(tb + 4096); ro1 = NTL4(tb + 4096 + 2048);                                                              \
    rd0 = NTL4(tb + 8192); rd1 = NTL4(tb + 8192 + 2048);                                                              \
    if (m) { rm0 = NTL4(tb + 12288); rm1 = NTL4(tb + 12288 + 2048); }                                                 \
    if (tid < 64) rrs = ((const float*)(P.ws + W_AUX))[(size_t)(m * 1024 + u1) * 128 + tid];                         \
  }
  const int et = tid >> 2, eq = tid & 3, ecol0 = h * 64 + 16 * eq;
  const int egcol = (m == 0 ? C_GLA_GATE : (m == 1 ? C_GDN_GATE : C_RW_GATE)) + ecol0;
  float* cgL = (float*)(lds + 36864 + 16640 + 256);
  if (tid < 64) {
    const float* gn0 = opq(P.in[13]); const float* gn1 = opq(P.in[27]);
    float g_ = 0.f, b_ = 0.f, m_ = 0.f;
    if (m == 0) g_ = gn0[layer * 64 + tid];
    else if (m == 1) g_ = gn1[layer * 64 + tid];
    else { g_ = P.in[36][layer * 256 + h * 64 + tid]; b_ = P.in[37][layer * 256 + h * 64 + tid]; m_ = P.in[28][layer * 896 + 512 + h * 64 + tid]; }
    cgL[tid] = g_; cgL[64 + tid] = b_; cgL[128 + tid] = m_;
  }
  const float* cg = cgL + 16 * eq; const float* cb = cgL + 64 + 16 * eq; const float* cm = cgL + 128 + 16 * eq;
  uint4 eg0, eg1, ex0, ex1, ep0, ep1, ng0, ng1, nx0, nx1, np0, np1;
  float bonus = 0.f, nbonus = 0.f;
  ex0 = make_uint4(0, 0, 0, 0); ex1 = ex0; ep0 = ex0; ep1 = ex0; nx0 = ex0; nx1 = ex0; np0 = ex0; np1 = ex0;
#define M2_ELOAD(cc)                                                                                                  \
  {                                                                                                                   \
    const u16* prow = proj + (size_t)(b * 2048 + (cc) * 64 + et) * PSTR;                                              \
    ng0 = *(const uint4*)(prow + egcol); ng1 = *(const uint4*)(prow + egcol + 8);                                     \
    if (m == 2) {                                                                                                     \
      nx0 = *(const uint4*)(prow + C_RW_V + ecol0); nx1 = *(const uint4*)(prow + C_RW_V + ecol0 + 8);                 \
      if ((cc) * 64 + et > 0) { np0 = *(const uint4*)(prow - PSTR + C_RW_V + ecol0); np1 = *(const uint4*)(prow - PSTR + C_RW_V + ecol0 + 8); } \
      else { np0 = make_uint4(0, 0, 0, 0); np1 = np0; }                                                               \
      nbonus = ((const float*)(P.ws + W_AUX))[(size_t)(m * 1024 + u0 + (cc)) * 128 + 64 + et];                        \
    }                                                                                                                 \
  }
  M2_GLOAD(0);
  M2_ELOAD(0);
  for (int c = 0; c < 32; ++c) {
    eg0 = ng0; eg1 = ng1; ex0 = nx0; ex1 = nx1; ep0 = np0; ep1 = np1; bonus = nbonus;
    *(uint4*)(QdT + lrow * 72 + lc8) = rq0; *(uint4*)(QdT + (lrow + 32) * 72 + lc8) = rq1;
    *(uint4*)(OlT + lrow * 72 + lc8) = ro0; *(uint4*)(OlT + (lrow + 32) * 72 + lc8) = ro1;
    *(uint4*)(dST + lrow * 72 + lc8) = rd0; *(uint4*)(dST + (lrow + 32) * 72 + lc8) = rd1;
    *(uint4*)(McT + lrow * 72 + lc8) = rm0; *(uint4*)(McT + (lrow + 32) * 72 + lc8) = rm1;
    if (tid < 64) rsA[tid] = rrs;
    __syncthreads();
    if (c < 31) { M2_GLOAD(c + 1); M2_ELOAD(c + 1); }
    f32x4 o[4], sn[4];
#pragma unroll
    for (int mt = 0; mt < 4; ++mt)
#pragma unroll
      for (int i = 0; i < 4; ++i) {
        const int row = mt * 16 + 4 * g4 + i;
        o[mt][i] = bf2f(OlT[row * 72 + 16 * wv + l16]);
        sn[mt][i] = rsA[row] * S[mt][i] + bf2f(dST[row * 72 + 16 * wv + l16]);
      }
    bf16x8 bS[2];
#pragma unroll
    for (int ks = 0; ks < 2; ++ks) {
      typedef __attribute__((ext_vector_type(4))) unsigned u32x4;
      u32x4 pk;
      pk[0] = pk2(S[2 * ks][0], S[2 * ks][1]); pk[1] = pk2(S[2 * ks][2], S[2 * ks][3]);
      pk[2] = pk2(S[2 * ks + 1][0], S[2 * ks + 1][1]); pk[3] = pk2(S[2 * ks + 1][2], S[2 * ks + 1][3]);
      bS[ks] = __builtin_bit_cast(bf16x8, pk);
    }
#pragma unroll
    for (int mt = 0; mt < 4; ++mt)
#pragma unroll
      for (int ks = 0; ks < 2; ++ks) {
        const bf16x4 lo = *(const bf16x4*)(QdT + (mt * 16 + l16) * 72 + ks * 32 + 4 * g4);
        const bf16x4 hi = *(const bf16x4*)(QdT + (mt * 16 + l16) * 72 + ks * 32 + 16 + 4 * g4);
        const bf16x8 a = __builtin_shufflevector(lo, hi, 0, 1, 2, 3, 4, 5, 6, 7);
        o[mt] = MFMA16(a, bS[ks], o[mt]);
        if (m) {
          const bf16x4 lo2 = *(const bf16x4*)(McT + (mt * 16 + l16) * 72 + ks * 32 + 4 * g4);
          const bf16x4 hi2 = *(const bf16x4*)(McT + (mt * 16 + l16) * 72 + ks * 32 + 16 + 4 * g4);
          const bf16x8 a2 = __builtin_shufflevector(lo2, hi2, 0, 1, 2, 3, 4, 5, 6, 7);
          sn[mt] = MFMA16(a2, bS[ks], sn[mt]);
        }
      }
#pragma unroll
    for (int mt = 0; mt < 4; ++mt) {
      S[mt] = sn[mt];
#pragma unroll
      for (int i = 0; i < 4; ++i) Ot[(mt * 16 + 4 * g4 + i) * 65 + 16 * wv + l16] = o[mt][i];
    }
    __syncthreads();
    {
      const int tok = b * 2048 + c * 64 + et;
      float ov[16];
#pragma unroll
      for (int j = 0; j < 16; ++j) ov[j] = Ot[et * 65 + 16 * eq + j];
      float sm = 0.f, ss = 0.f;
#pragma unroll
      for (int j = 0; j < 16; ++j) { sm += ov[j]; ss += ov[j] * ov[j]; }
      sm = qsum(sm); ss = qsum(ss);
      const float mu = m == 2 ? sm * (1.f / 64.f) : 0.f;
      const float r = m == 2 ? rsqrtf(fmaxf(ss * (1.f / 64.f) - mu * mu, 0.f) + 64e-5f) : rsqrtf(ss * (1.f / 64.f) + 1e-6f);
      float gate[16], outv[16];
      unpk8(eg0, gate); unpk8(eg1, gate + 8);
      if (m == 2) {
        float xv[16], pv[16];
        unpk8(ex0, xv); unpk8(ex1, xv + 8); unpk8(ep0, pv); unpk8(ep1, pv + 8);
#pragma unroll
        for (int j = 0; j < 16; ++j) {
          const float vs = xv[j] + (pv[j] - xv[j]) * cm[j];
          outv[j] = ((ov[j] - mu) * r * cg[j] + cb[j] + bonus * vs) * silu(gate[j]);
        }
      } else {
#pragma unroll
        for (int j = 0; j < 16; ++j) outv[j] = ov[j] * r * cg[j] * silu(gate[j]);
      }
      u16* mixed = (u16*)(P.ws + W_HB);
      st16(mixed + (size_t)tok * 1024 + (m == 0 ? 0 : (m == 1 ? 512 : 768)) + ecol0, outv);
    }
  }
#undef M2_GLOAD
#undef M2_ELOAD
  const size_t sbase = ((size_t)(layer * 8 + b) * 4 + h) * 4096;
  float* sout = P.out + (m == 0 ? O_GLA_P : (m == 1 ? O_GDN_P : O_RW_P)) + sbase;
#pragma unroll
  for (int kt = 0; kt < 4; ++kt)
#pragma unroll
    for (int i = 0; i < 4; ++i) {
      const int k = kt * 16 + 4 * g4 + i, v = 16 * wv + l16;
      if (m == 2) sout[v * 64 + k] = S[kt][i]; else sout[k * 64 + v] = S[kt][i];
    }
  __syncthreads();
}

DI void s5_unit(const Params& P, int layer, int kind, bool sample, int bs, int c, int ghalf, char* lds) {
  int tid_ = threadIdx.x; asm volatile("" : "+v"(tid_));
  const int tid = tid_, wave = tid >> 6, lane = tid & 63, l16 = lane & 15, g4 = lane >> 4;
  u16* BUw = (u16*)lds + wave * 2176;
  u16* Hw = (u16*)(lds + 17408) + wave * 2176;
  u16* Yt = (u16*)(lds + 34816);
  const u16* proj = (const u16*)(P.ws + W_PROJ);
  const float* sp = (const float*)(P.ws + W_S5P);
  const u16* bbt = (const u16*)(P.ws + W_S5P + 16384);
  const u16* cmt = bbt + 16 * 128 * 16;
  const int tok0 = sample ? TP + bs * 64 : bs * 2048 + c * 64;
  const bf16x8 zero8 = (bf16x8){0, 0, 0, 0, 0, 0, 0, 0};
  const int ngi = kind == 0 ? 2 : 4;
  for (int gi = 0; gi < ngi; ++gi) {
    const int g = kind == 0 ? ghalf * 8 + wave * 2 + gi : wave * 4 + gi;
    const int p = lane;
    const float abr = sp[g * 64 + p], abi = sp[1024 + g * 64 + p];
    bf16x8 bfr[8], cfr[4];
#pragma unroll
    for (int nt = 0; nt < 8; ++nt) bfr[nt] = g4 < 2 ? *(const bf16x8*)(bbt + (g * 128 + nt * 16 + l16) * 16 + g4 * 8) : zero8;
#pragma unroll
    for (int ks = 0; ks < 4; ++ks) cfr[ks] = *(const bf16x8*)(cmt + (g * 16 + l16) * 128 + ks * 32 + g4 * 8);
    float hr = 0.f, hi = 0.f;
    if (kind == 1 && !sample) {
      const float lr = sp[2048 + g * 64 + p], li = sp[3072 + g * 64 + p];
      const float* E = (const float*)(P.ws + W_S5E) + ((size_t)(bs * 32) * 16 + g) * 128;
      for (int c2 = 0; c2 < c; ++c2) {
        const float er = E[(size_t)c2 * 2048 + p], ei = E[(size_t)c2 * 2048 + 64 + p];
        const float nr = lr * hr - li * hi + er, ni = lr * hi + li * hr + ei;
        hr = nr; hi = ni;
      }
    }
    const float dch = P.in[21][layer * 256 + g * 16 + l16];
    bf16x8 afr[4];
    u16 uraw[16];
#pragma unroll
    for (int sub = 0; sub < 4; ++sub) {
      afr[sub] = g4 < 2 ? *(const bf16x8*)(proj + (size_t)(tok0 + sub * 16 + l16) * PSTR + C_S5_U + g * 16 + g4 * 8) : zero8;
#pragma unroll
      for (int i = 0; i < 4; ++i) uraw[sub * 4 + i] = (kind == 1) ? proj[(size_t)(tok0 + sub * 16 + 4 * g4 + i) * PSTR + C_S5_U + g * 16 + l16] : (u16)0;
    }
#pragma unroll
    for (int sub = 0; sub < 4; ++sub) {
      {
        const bf16x8 a = afr[sub];
#pragma unroll
        for (int nt = 0; nt < 8; ++nt) {
          f32x4 acc = (f32x4){0.f, 0.f, 0.f, 0.f};
          acc = MFMA16(a, bfr[nt], acc);
#pragma unroll
          for (int i = 0; i < 4; ++i) BUw[(4 * g4 + i) * 136 + nt * 16 + l16] = f2bf(acc[i]);
        }
      }
      float s0r[16], s0i[16];
      if (sample) {
#pragma unroll
        for (int tt = 0; tt < 16; ++tt) {
          const size_t si = (((size_t)layer * 128 + bs * 64 + sub * 16 + tt) * 16 + g) * 64 + p;
          s0r[tt] = P.in[3][si]; s0i[tt] = P.in[4][si];
        }
      }
      __builtin_amdgcn_fence(__ATOMIC_ACQ_REL, "wavefront"); __builtin_amdgcn_wave_barrier();
#pragma unroll
      for (int tt = 0; tt < 16; ++tt) {
        const float br = bf2f(BUw[tt * 136 + p]), bi = bf2f(BUw[tt * 136 + 64 + p]);
        if (sample) { hr = s0r[tt]; hi = s0i[tt]; }
        const float nr = abr * hr - abi * hi + br, ni = abr * hi + abi * hr + bi;
        hr = nr; hi = ni;
        if (kind == 1) { Hw[tt * 136 + p] = f2bf(hr); Hw[tt * 136 + 64 + p] = f2bf(hi); }
        if (sample) {
          const size_t si = (((size_t)layer * 128 + bs * 64 + sub * 16 + tt) * 16 + g) * 64 + p;
          P.out[O_S5R_S + si] = hr; P.out[O_S5I_S + si] = hi;
        }
      }
      __builtin_amdgcn_fence(__ATOMIC_ACQ_REL, "wavefront"); __builtin_amdgcn_wave_barrier();
      if (kind == 1) {
        f32x4 y = (f32x4){0.f, 0.f, 0.f, 0.f};
#pragma unroll
        for (int ks = 0; ks < 4; ++ks) {
          const bf16x8 a = *(const bf16x8*)(Hw + l16 * 136 + ks * 32 + g4 * 8);
          y = MFMA16(a, cfr[ks], y);
        }
#pragma unroll
        for (int i = 0; i < 4; ++i) {
          const int trow = sub * 16 + 4 * g4 + i;
          const float u = bf2f(uraw[sub * 4 + i]);
          const float yv = y[i] + dch * u;
          const float ge = 0.5f * yv * (1.f + ftanh(0.7978845608028654f * (yv + 0.044715f * yv * yv * yv)));
          Yt[trow * 264 + g * 16 + l16] = f2bf(ge);
        }
      }
    }
    if (kind == 0) {
      float* E = (float*)(P.ws + W_S5E) + ((size_t)(bs * 32 + c) * 16 + g) * 128;
      E[p] = hr; E[64 + p] = hi;
    } else if (!sample && c == 31) {
      const size_t si = (((size_t)layer * 8 + bs) * 16 + g) * 64 + p;
      P.out[O_S5R_P + si] = hr; P.out[O_S5I_P + si] = hi;
    }
  }
  __syncthreads();
  if (kind == 1) {
    const u16* wg = (const u16*)(P.ws + W_WGLU);
    f32x4 acc[4][4];
#pragma unroll
    for (int i = 0; i < 4; ++i)
#pragma unroll
      for (int j = 0; j < 4; ++j) acc[i][j] = (f32x4){0.f, 0.f, 0.f, 0.f};
    for (int ks = 0; ks < 8; ++ks) {
      bf16x8 a[4], bb[4];
#pragma unroll
      for (int mt = 0; mt < 4; ++mt) a[mt] = *(const bf16x8*)(Yt + (mt * 16 + l16) * 264 + ks * 32 + g4 * 8);
#pragma unroll
      for (int nt = 0; nt < 4; ++nt) bb[nt] = *(const bf16x8*)(wg + (size_t)(64 * wave + nt * 16 + l16) * 256 + ks * 32 + g4 * 8);
#pragma unroll
      for (int mt = 0; mt < 4; ++mt)
#pragma unroll
        for (int nt = 0; nt < 4; ++nt) acc[mt][nt] = MFMA16(a[mt], bb[nt], acc[mt][nt]);
    }
    u16* mixed = (u16*)(P.ws + W_HB);
#pragma unroll
    for (int nt = 0; nt < 4; ++nt) {
      const int n = 64 * wave + nt * 16 + l16;
      const float bgl = P.in[23][layer * 256 + n];
#pragma unroll
      for (int mt = 0; mt < 4; ++mt)
#pragma unroll
        for (int i = 0; i < 4; ++i) {
          const int trow = mt * 16 + 4 * g4 + i;
          const float yv = bf2f(Yt[trow * 264 + n]);
          const float gate = bf2f(proj[(size_t)(tok0 + trow) * PSTR + C_S5_GATE + n]);
          mixed[(size_t)(tok0 + trow) * 1024 + 256 + n] = f2bf(yv * sigm(acc[mt][nt][i] + bgl) * silu(gate));
        }
    }
  }
  __syncthreads();
}

DI void step_unit_w(const Params& P, int layer, int m, int seq, char* lds) {
  int tid_ = threadIdx.x; asm volatile("" : "+v"(tid_));
  const int tid = tid_, h = tid >> 6, lane = tid & 63, hd = h * 64 + lane;
  float* vecs = (float*)lds + h * 320;
  const int tok = TP + seq;
  const u16* prow = (const u16*)(P.ws + W_PROJ) + (size_t)tok * PSTR;
  const size_t sbase = ((size_t)(layer * 128 + seq) * 4 + h) * 4096;
  const float* si0 = opq(P.in[2]); const float* si1 = opq(P.in[5]); const float* si2 = opq(P.in[7]);
  const float* sin = (m == 0 ? si0 : (m == 1 ? si1 : si2)) + sbase;
  float* sout = P.out + (m == 0 ? O_GLA_S : (m == 1 ? O_GDN_S : O_RW_S)) + sbase;
  float S[64];
  if (m == 2) {
#pragma unroll
    for (int i = 0; i < 16; ++i) {
      const f32x4 x = __builtin_nontemporal_load((const f32x4*)(sin + lane * 64 + 4 * i));
      S[4 * i] = x[0]; S[4 * i + 1] = x[1]; S[4 * i + 2] = x[2]; S[4 * i + 3] = x[3];
    }
  } else {
#pragma unroll
    for (int k = 0; k < 64; ++k) S[k] = __builtin_nontemporal_load(sin + k * 64 + lane);
  }
  float al = 0.f, be = 0.f, kr = 0.f, qv = 0.f, vv = 0.f, w = 1.f, bonus = 0.f;
  int gcol;
  if (m == 0) {
    gcol = C_GLA_GATE + hd;
    const float q = bf2f(prow[C_GLA_Q + hd]), k = bf2f(prow[C_GLA_K + hd]);
    vv = bf2f(prow[C_GLA_V + hd]);
    float x = P.in[12][layer * 256 + hd];
    const float* wg = P.in[11] + (size_t)layer * 16 * 256 + hd;
#pragma unroll
    for (int r = 0; r < 16; ++r) x += bf2f(prow[C_GLA_GLR + r]) * wg[r * 256];
    w = __expf(-softplus(-x) * (1.f / 16.f));
    kr = k; qv = q * 0.125f;
  } else if (m == 1) {
    gcol = C_GDN_GATE + hd;
    const float* cst = P.in[6] + ((size_t)layer * 128 + seq) * 2304;
    const float* cw = P.in[24] + (size_t)layer * 3072;
    float qkv[3];
#pragma unroll
    for (int part = 0; part < 3; ++part) {
      const int col = part * 256 + hd;
      float acc = bf2f(prow[C_GDN_Q + col]) * cw[3 * 768 + col];
#pragma unroll
      for (int jj = 1; jj <= 3; ++jj) acc += cst[(3 - jj) * 768 + col] * cw[(3 - jj) * 768 + col];
      qkv[part] = silu(acc);
    }
    const float sq = wsum(qkv[0] * qkv[0]), sk = wsum(qkv[1] * qkv[1]);
    const float rq = rsqrtf(sq + 1e-6f) * 0.125f, rk = rsqrtf(sk + 1e-6f);
    const float a_raw = bf2f(prow[C_GDN_A + h]), b_raw = bf2f(prow[C_GDN_B + h]);
    const float gg = -__expf(P.in[25][layer * 4 + h]) * softplus(a_raw + P.in[26][layer * 4 + h]);
    const float beta = sigm(b_raw), eg = __expf(gg);
    const float k = qkv[1] * rk;
    al = k; be = -eg * beta * k; kr = beta * k; qv = qkv[0] * rq; vv = qkv[2]; w = eg;
  } else {
    gcol = C_RW_GATE + hd;
    const float* sst = P.in[8] + ((size_t)layer * 128 + seq) * 896;
    const float* mu = P.in[28] + layer * 896;
    float xs[5];
#pragma unroll
    for (int part = 0; part < 5; ++part) {
      const int col = part < 3 ? part * 256 + hd : (part == 3 ? 768 + lane : 832 + lane);
      const float x = bf2f(prow[C_RW_R + col]);
      xs[part] = x + (sst[col] - x) * mu[col];
    }
    const float twl = ftanh(xs[3]), tal = xs[4];
    const float* ww2 = P.in[30] + (size_t)layer * 64 * 256 + hd;
    const float* wa2 = P.in[32] + (size_t)layer * 64 * 256 + hd;
    float wl = 0.f, alr = 0.f;
#pragma unroll 8
    for (int r = 0; r < 64; ++r) { wl += __shfl(twl, r) * ww2[r * 256]; alr += __shfl(tal, r) * wa2[r * 256]; }
    const float wraw = -softplus(-(P.in[29][layer * 256 + hd] + wl)) - 0.5f;
    w = __expf(-__expf(wraw));
    const float a = sigm(P.in[31][layer * 256 + hd] + alr);
    const float kkv = xs[1] * P.in[33][layer * 256 + hd];
    const float kk = kkv * rsqrtf(wsum(kkv * kkv) + 1e-6f);
    kr = xs[1] * (1.f + (a - 1.f) * P.in[34][layer * 256 + hd]);
    bonus = wsum(xs[0] * kr * P.in[35][layer * 256 + hd]);
    al = kk; be = -(kk * a); qv = xs[0]; vv = xs[2];
  }
  vecs[lane] = al; vecs[64 + lane] = be; vecs[128 + lane] = kr; vecs[192 + lane] = qv; vecs[256 + lane] = w;
  __builtin_amdgcn_fence(__ATOMIC_ACQ_REL, "wavefront"); __builtin_amdgcn_wave_barrier();
  float z = 0.f;
#pragma unroll
  for (int k = 0; k < 64; ++k) z += vecs[k] * S[k];
  float o = 0.f;
#pragma unroll
  for (int k = 0; k < 64; ++k) {
    S[k] = vecs[256 + k] * S[k] + vecs[64 + k] * z + vecs[128 + k] * vv;
    o += vecs[192 + k] * S[k];
  }
  if (m == 2) {
#pragma unroll
    for (int i = 0; i < 16; ++i) {
      const f32x4 x = {S[4 * i], S[4 * i + 1], S[4 * i + 2], S[4 * i + 3]};
      __builtin_nontemporal_store(x, (f32x4*)(sout + lane * 64 + 4 * i));
    }
  } else {
#pragma unroll
    for (int k = 0; k < 64; ++k) __builtin_nontemporal_store(S[k], sout + k * 64 + lane);
  }
  const float gate = bf2f(prow[gcol]);
  float outv;
  if (m < 2) {
    const float* gn0 = opq(P.in[13]); const float* gn1 = opq(P.in[27]);
    const float gn = (m == 0 ? gn0 : gn1)[layer * 64 + lane];
    const float r = rsqrtf(wsum(o * o) * (1.f / 64.f) + 1e-6f);
    outv = o * r * gn * silu(gate);
  } else {
    const float mu_ = wsum(o) * (1.f / 64.f);
    const float dv = o - mu_;
    const float r = rsqrtf(wsum(dv * dv) * (1.f / 64.f) + 64e-5f);
    outv = (dv * r * P.in[36][layer * 256 + hd] + P.in[37][layer * 256 + hd] + bonus * vv) * silu(gate);
  }
  u16* mixed = (u16*)(P.ws + W_HB);
  mixed[(size_t)tok * 1024 + (m == 0 ? 0 : (m == 1 ? 512 : 768)) + hd] = f2bf(outv);
  if (m == 1) {
    const float* cst = P.in[6] + ((size_t)layer * 128 + seq) * 2304;
    float* co = P.out + O_CONV_S + ((size_t)layer * 128 + seq) * 2304;
    for (int e = tid; e < 2304; e += 256) {
      const int rrow = e / 768, cc = e % 768;
      co[e] = rrow < 2 ? cst[(rrow + 1) * 768 + cc] : bf2f(prow[C_GDN_Q + cc]);
    }
  }
  if (m == 2) {
    float* so = P.out + O_SH_S + ((size_t)layer * 128 + seq) * 896;
    for (int e = tid; e < 896; e += 256) so[e] = bf2f(prow[C_RW_R + e]);
  }
  __syncthreads();
}

DI void phase_mix(const Params& P, int layer, int second, char* lds) {
  if (second && blockIdx.x < 96) {
    const int u = blockIdx.x;
    m2_unit(P, layer, u >> 5, (u & 31) >> 2, u & 3, lds);
    return;
  }
  const int u0 = second ? blockIdx.x - 96 : blockIdx.x;
  const int stride = second ? gridDim.x - 96 : gridDim.x;
  const int n = second ? 258 + 384 : 3072 + 512;
  for (int u = u0; u < n; u += stride) {
    const bool is_s5 = second ? (u < 258) : (u >= 3072);
    if (is_s5) {
      const int v = second ? u : u - 3072;
      const bool smp = second && v >= 256;
      if (!second) s5_unit(P, layer, 0, false, v >> 6, (v >> 1) & 31, v & 1, lds);
      else if (!smp) s5_unit(P, layer, 1, false, v >> 5, v & 31, 0, lds);
      else s5_unit(P, layer, 1, true, v - 256, 0, 0, lds);
    } else if (second) {
      const int v = u - 258;
      step_unit_w(P, layer, v >> 7, v & 127, lds);
    } else {
      const int r = u & 1023;
      mix_unit(P, layer, 2 - (u >> 10), 0, r >> 7, (r >> 5) & 3, r & 31, lds);
    }
  }
}
DI void phase_final(const Params& P) {
  int tid_ = threadIdx.x; asm volatile("" : "+v"(tid_));
  const int tid = tid_, wave = tid >> 6, lane = tid & 63;
  const float* g = P.in[39];
  int r = blockIdx.x * 4 + wave;
  float4 v[4], nv[4];
  if (r < TT) {
    const float4* x = (const float4*)(P.out + (size_t)r * 1024);
#pragma unroll
    for (int i = 0; i < 4; ++i) v[i] = x[lane + 64 * i];
  }
  for (; r < TT; r += gridDim.x * 4) {
    const int rn = r + gridDim.x * 4;
    if (rn < TT) {
      const float4* xn = (const float4*)(P.out + (size_t)rn * 1024);
#pragma unroll
      for (int i = 0; i < 4; ++i) nv[i] = xn[lane + 64 * i];
    }
    float4* x = (float4*)(P.out + (size_t)r * 1024);
    if (r >= TP) {
      const float4* pp = (const float4*)(P.ws + W_PART) + (size_t)(r - TP) * 256;
#pragma unroll
      for (int kq = 0; kq < 4; ++kq)
#pragma unroll
        for (int i = 0; i < 4; ++i) {
          const float4 pv = pp[(size_t)kq * 128 * 256 + lane + 64 * i];
          v[i].x += pv.x; v[i].y += pv.y; v[i].z += pv.z; v[i].w += pv.w;
        }
    }
    float ss = 0.f;
#pragma unroll
    for (int i = 0; i < 4; ++i) ss += v[i].x * v[i].x + v[i].y * v[i].y + v[i].z * v[i].z + v[i].w * v[i].w;
    ss = wsum(ss);
    const float rs = rsqrtf(ss * (1.f / 1024.f) + 1e-6f);
#pragma unroll
    for (int i = 0; i < 4; ++i) {
      float4 gg = ((const float4*)g)[lane + 64 * i];
      x[lane + 64 * i] = make_float4(v[i].x * rs * gg.x, v[i].y * rs * gg.y, v[i].z * rs * gg.z, v[i].w * rs * gg.w);
    }
#pragma unroll
    for (int i = 0; i < 4; ++i) v[i] = nv[i];
  }
}

#define XB_TMO      128
#define XB_XCNT(j)  (256  + 64 * (j))
#define XB_XSUB(j)  (1280 + 64 * (j))
#define XB_XGEN(j)  (2304 + 64 * (j))
#define XB_TOP      3328
#define XB_TOPGEN   3392
#define XCD_BAR_WORDS 3456
#define XB_SPIN_CAP (1u << 22)
#define LAS __attribute__((address_space(3)))
DI unsigned xb_ld(unsigned* p) { return __hip_atomic_load(p, __ATOMIC_RELAXED, __HIP_MEMORY_SCOPE_AGENT); }
DI unsigned xb_add(unsigned* p, unsigned v) { return __hip_atomic_fetch_add(p, v, __ATOMIC_RELAXED, __HIP_MEMORY_SCOPE_AGENT); }
DI unsigned xb_xcc_id() { return (unsigned)__builtin_amdgcn_s_getreg((3 << 11) | 20) & 0xFu; }
#define XB_SPIN(cond, bar) do { unsigned _sp = 0; while (cond) { __builtin_amdgcn_s_sleep(8); \
    if ((++_sp & 255u) == 0u) { if (xb_ld(&(bar)[XB_TMO])) break; if (_sp > XB_SPIN_CAP) { atomicAdd(&(bar)[XB_TMO], 1u); break; } } } } while (0)
struct XcdBarrier { unsigned* bar; unsigned x; volatile LAS unsigned* st; };
DI XcdBarrier xcd_barrier_post(unsigned* bar, volatile LAS unsigned* st) {
  XcdBarrier b; b.bar = bar; b.x = xb_xcc_id(); b.st = st;
  if (threadIdx.x == 0) (void)xb_add(&bar[XB_XCNT(b.x)], 1u);
  return b;
}
DI void xcd_barrier_complete(unsigned* bar, unsigned x, unsigned& nloc, unsigned& nx) {
  const unsigned G = gridDim.x * gridDim.y * gridDim.z;
  unsigned sum, cnt, mine, sp = 0u;
  for (;;) {
    sum = 0u; cnt = 0u; mine = 0u;
#pragma unroll
    for (unsigned j = 0; j < 16; ++j) { const unsigned c = xb_ld(&bar[XB_XCNT(j)]); sum += c; cnt += (c > 0u) ? 1u : 0u; mine = (j == x) ? c : mine; }
    if (sum == G) break;
    __builtin_amdgcn_s_sleep(1);
    if ((++sp & 255u) == 0u) { if (xb_ld(&bar[XB_TMO])) break; if (sp > XB_SPIN_CAP) { atomicAdd(&bar[XB_TMO], 1u); break; } }
  }
  nloc = mine > 0u ? mine : 1u; nx = cnt > 0u ? cnt : 1u;
}
DI void xcd_barrier(const XcdBarrier& b) {
  asm volatile("s_waitcnt vmcnt(0)" ::: "memory");
  __syncthreads();
  if (threadIdx.x == 0) {
    unsigned* bar = b.bar;
    __builtin_amdgcn_s_waitcnt(0);
    unsigned nloc = b.st[0], nx = b.st[1];
    if (nloc == 0u) { xcd_barrier_complete(bar, b.x, nloc, nx); b.st[0] = nloc; b.st[1] = nx; }
    const unsigned old = xb_add(&bar[XB_XSUB(b.x)], 1u);
    const unsigned gen = old / nloc;
    if (old + 1u == (gen + 1u) * nloc) {
      __builtin_amdgcn_fence(__ATOMIC_RELEASE, "agent");
      asm volatile("s_waitcnt vmcnt(0)" ::: "memory");
      const unsigned og = xb_add(&bar[XB_TOP], 1u);
      const unsigned tg = og / nx;
      if (og + 1u == (tg + 1u) * nx) xb_add(&bar[XB_TOPGEN], 1u);
      else XB_SPIN(xb_ld(&bar[XB_TOPGEN]) == tg, bar);
      __builtin_amdgcn_fence(__ATOMIC_ACQUIRE, "agent");
      xb_add(&bar[XB_XGEN(b.x)], 1u);
      asm volatile("s_waitcnt vmcnt(0)" ::: "memory");
    } else {
      XB_SPIN(xb_ld(&bar[XB_XGEN(b.x)]) == gen, bar);
      __builtin_amdgcn_fence(__ATOMIC_ACQUIRE, "agent");
      asm volatile("s_waitcnt vmcnt(0)" ::: "memory");
    }
  }
  __syncthreads();
}

__global__ void __launch_bounds__(256, 2) mega(Params P, int ph_lo, int ph_hi, int coop) {
  __shared__ __attribute__((aligned(16))) char lds[LDS_BYTES];
  __shared__ uint4 xb_words;
  if (ph_lo < 0) cg::this_grid().sync();
  XcdBarrier xb;
  if (coop) {
    if (threadIdx.x == 0) xb_words = make_uint4(0u, 0u, 0u, 0u);
    __syncthreads();
    xb = xcd_barrier_post((unsigned*)(P.ws + W_BAR), (volatile LAS unsigned*)&xb_words);
  }
  for (int ph = ph_lo; ph < ph_hi; ++ph) {
    if (ph == NPH - 1) phase_final(P);
    else {
      const int layer = ph / PER, k_ = ph % PER;
      const int s = (DUP_S >= 0 && k_ > DUP_S) ? k_ - 1 : k_;
      if (s == 0) phase_norm(P, layer, lds);
      else if (s == 1) phase_gemm1(P, layer, lds);
      else if (s == 2 || s == 3) phase_mix(P, layer, s - 2, lds);
      else phase_gemm2(P, layer, lds);
    }
    if (coop && ph + 1 < ph_hi) xcd_barrier(xb);
  }
}

extern "C" void kernel_launch(void* const* d_in, const int* in_sizes, int n_in, void* d_out, int out_size, void* d_ws,
                              size_t ws_size, hipStream_t stream) {
  static int grid_blocks = 0;
  if (!grid_blocks) {
    int dev = 0, cus = 0, per_cu = 0;
    (void)hipGetDevice(&dev);
    (void)hipDeviceGetAttribute(&cus, hipDeviceAttributeMultiprocessorCount, dev);
    (void)hipOccupancyMaxActiveBlocksPerMultiprocessor(&per_cu, mega, 256, 0);
    if (per_cu < 1) per_cu = 1;
    if (per_cu > 2) per_cu = 2;
    grid_blocks = cus * per_cu;
    if (ws_size < W_END) fprintf(stderr, "workspace too small: %zu < %zu\n", ws_size, (size_t)W_END);
  }
  Params p;
  memset(&p, 0, sizeof(p));
  for (int i = 0; i < 40; ++i) p.in[i] = (const float*)d_in[i];
  p.out = (float*)d_out;
  p.ws = (char*)d_ws;
#if COOP
  (void)hipMemsetAsync((char*)d_ws + W_BAR, 0, 16384, stream);
  int lo = 0, hi = NPH, coop = 1;
  void* args[] = {&p, &lo, &hi, &coop};
  hipError_t e = hipLaunchCooperativeKernel((void*)mega, dim3(grid_blocks), dim3(256), args, 0, stream);
  if (e != hipSuccess) fprintf(stderr, "cooperative launch failed: %s (grid %d)\n", hipGetErrorString(e), grid_blocks);
#else
  for (int ph = 0; ph < NPH; ++ph) mega<<<grid_blocks, 256, 0, stream>>>(p, ph, ph + 1, 0);
#endif
}
```

```cpp
#include <hip/hip_runtime.h>
#include <hip/hip_cooperative_groups.h>
#include <cstdio>
#include <cstring>
namespace cg = cooperative_groups;

#ifndef COOP
#define COOP 1
#endif
#define DUP_S (-1)
#define PER (DUP_S >= 0 ? 6 : 5)
#define NPH (4 * PER + 1)

typedef unsigned short u16;
typedef __attribute__((ext_vector_type(8))) short bf16x8;
typedef __attribute__((ext_vector_type(4))) short bf16x4;
typedef __attribute__((ext_vector_type(4))) float f32x4;
#define DI __device__ __forceinline__
#define MFMA16(a, b, c) __builtin_amdgcn_mfma_f32_16x16x32_bf16((a), (b), (c), 0, 0, 0)

constexpr int TP = 16384, TT = 16512, PSTR = 3744, NLAY = 4;
constexpr int C_GLA_Q = 0, C_GLA_K = 256, C_GLA_V = 512, C_GLA_GLR = 768, C_GLA_GATE = 784;
constexpr int C_S5_U = 1040, C_S5_GATE = 1296;
constexpr int C_GDN_Q = 1552, C_GDN_A = 2320, C_GDN_B = 2324, C_GDN_GATE = 2328;
constexpr int C_RW_R = 2584, C_RW_V = 3096, C_RW_WL = 3352, C_RW_AL = 3416, C_RW_GATE = 3480;
constexpr size_t O_Y = 0;
constexpr size_t O_GLA_P = 16908288, O_S5R_P = 17432576, O_S5I_P = 17465344, O_GDN_P = 17498112, O_CONV_P = 18022400,
                 O_RW_P = 18096128, O_SH_P = 18620416, O_GLA_S = 18649088, O_S5R_S = 27037696, O_S5I_S = 27561984,
                 O_GDN_S = 28086272, O_CONV_S = 36474880, O_RW_S = 37654528, O_SH_S = 46043136;
constexpr size_t W_PROJ = 0;
constexpr size_t W_HB = W_PROJ + (size_t)TT * PSTR * 2;
constexpr size_t W_WIN = W_HB + (size_t)TT * 1024 * 2;
constexpr size_t W_WOUT = W_WIN + (size_t)3840 * 1024 * 2;
constexpr size_t W_WGLU = W_WOUT + (size_t)1024 * 1024 * 2;
constexpr size_t W_WW2 = W_WGLU + 131072;
constexpr size_t W_WA2 = W_WW2 + 32768;
constexpr size_t W_S5P = W_WA2 + 32768;
constexpr size_t W_S5E = W_S5P + 147456;
constexpr size_t W_AUX = W_S5E + 2097152;
constexpr size_t W_TILES = W_AUX + 1572864;
constexpr size_t W_BAR = W_TILES + (size_t)11 * 8192 * 1024;
constexpr size_t W_PART = W_BAR + 16384;
constexpr size_t W_END = W_PART + (size_t)4 * 128 * 1024 * 4;

constexpr int LDS_BYTES = 74752;

struct Params {
  const float* in[40];
  float* out;
  char* ws;
};

DI float bf2f(u16 h) { return __uint_as_float(((unsigned)h) << 16); }
typedef __attribute__((ext_vector_type(2))) float f32x2_t;
typedef __attribute__((ext_vector_type(2))) __bf16 bf16x2_t;
DI unsigned pk2(float a, float b) { f32x2_t v = {a, b}; bf16x2_t r = __builtin_convertvector(v, bf16x2_t); return __builtin_bit_cast(unsigned, r); }
DI u16 f2bf(float f) { return (u16)(pk2(f, f) & 0xffffu); }
DI void unpk8(uint4 a, float* o) {
  o[0] = __uint_as_float(a.x << 16); o[1] = __uint_as_float(a.x & 0xffff0000u);
  o[2] = __uint_as_float(a.y << 16); o[3] = __uint_as_float(a.y & 0xffff0000u);
  o[4] = __uint_as_float(a.z << 16); o[5] = __uint_as_float(a.z & 0xffff0000u);
  o[6] = __uint_as_float(a.w << 16); o[7] = __uint_as_float(a.w & 0xffff0000u);
}
DI void ld16(const u16* p, float* o) { unpk8(*(const uint4*)p, o); unpk8(*(const uint4*)(p + 8), o + 8); }
DI void st16(u16* p, const float* v) {
  uint4 a, b;
  a.x = pk2(v[0], v[1]); a.y = pk2(v[2], v[3]); a.z = pk2(v[4], v[5]); a.w = pk2(v[6], v[7]);
  b.x = pk2(v[8], v[9]); b.y = pk2(v[10], v[11]); b.z = pk2(v[12], v[13]); b.w = pk2(v[14], v[15]);
  *(uint4*)p = a; *(uint4*)(p + 8) = b;
}
typedef __attribute__((ext_vector_type(4))) unsigned u32x4v;
DI uint4 ntl4(const u16* p) { const u32x4v v = __builtin_nontemporal_load((const u32x4v*)p); return make_uint4(v[0], v[1], v[2], v[3]); }
#define NTL4(p) ntl4(p)
DI float sigm(float x) { return __builtin_amdgcn_rcpf(1.f + __expf(-x)); }
DI float silu(float x) { return x * sigm(x); }
DI float softplus(float x) { return fmaxf(x, 0.f) + __logf(1.f + __expf(-fabsf(x))); }
DI float ftanh(float x) { const float e = __expf(-2.f * fabsf(x)); const float r = (1.f - e) * __builtin_amdgcn_rcpf(1.f + e); return x < 0.f ? -r : r; }
DI float wsum(float v) { for (int o = 32; o; o >>= 1) v += __shfl_xor(v, o); return v; }
DI float qsum(float v) { v += __shfl_xor(v, 1); v += __shfl_xor(v, 2); return v; }

DI const float* opq(const float* p) { asm volatile("" : "+s"(p)); return p; }
DI const float* xrow(const Params& P, int layer, int r) {
  const float* xp = opq(P.in[0]); const float* xs = opq(P.in[1]); const float* xo = opq(P.out);
  if (layer == 0) return r < TP ? xp + (size_t)r * 1024 : xs + (size_t)(r - TP) * 1024;
  return xo + (size_t)r * 1024;
}

DI void tr_tile(const float* src, int N, int ld, u16* dst, int K, int k0, int n0, float* T) {
  int tid_ = threadIdx.x; asm volatile("" : "+v"(tid_));
  const int tid = tid_;
  const int kk = tid >> 4, n4 = (tid & 15) * 4;
#pragma unroll
  for (int p = 0; p < 4; ++p) {
    int k = kk + 16 * p;
    float4 v = make_float4(0.f, 0.f, 0.f, 0.f);
    if (n0 + n4 < N) v = *(const float4*)(src + (size_t)(k0 + k) * ld + n0 + n4);
    T[k * 65 + n4] = v.x; T[k * 65 + n4 + 1] = v.y; T[k * 65 + n4 + 2] = v.z; T[k * 65 + n4 + 3] = v.w;
  }
  __syncthreads();
  const int n = tid >> 2, kq = (tid & 3) * 16;
  float v[16];
#pragma unroll
  for (int j = 0; j < 16; ++j) v[j] = T[(kq + j) * 65 + n];
  st16(dst + (size_t)(n0 + n) * K + k0 + kq, v);
  __syncthreads();
}

DI void phase_norm(const Params& P, int layer, char* lds) {
  int tid_ = threadIdx.x; asm volatile("" : "+v"(tid_));
  const int tid = tid_, wave = tid >> 6, lane = tid & 63;
  u16* hb = (u16*)(P.ws + W_HB);
  const float* g = P.in[9] + layer * 1024;
  {
    int r = blockIdx.x * 4 + wave;
    float4 v[4], nv[4];
    if (r < TT) {
      const float4* x = (const float4*)xrow(P, layer, r);
#pragma unroll
      for (int i = 0; i < 4; ++i) { const f32x4 t_ = __builtin_nontemporal_load((const f32x4*)(x + lane + 64 * i)); v[i] = make_float4(t_[0], t_[1], t_[2], t_[3]); }
    }
    for (; r < TT; r += gridDim.x * 4) {
      const int rn = r + gridDim.x * 4;
      if (rn < TT) {
        const float4* xn = (const float4*)xrow(P, layer, rn);
#pragma unroll
        for (int i = 0; i < 4; ++i) { const f32x4 t_ = __builtin_nontemporal_load((const f32x4*)(xn + lane + 64 * i)); nv[i] = make_float4(t_[0], t_[1], t_[2], t_[3]); }
      }
      if (layer > 0 && r >= TP) {
        const float4* pp = (const float4*)(P.ws + W_PART) + (size_t)(r - TP) * 256;
#pragma unroll
        for (int kq = 0; kq < 4; ++kq)
#pragma unroll
          for (int i = 0; i < 4; ++i) {
            const float4 pv = pp[(size_t)kq * 128 * 256 + lane + 64 * i];
            v[i].x += pv.x; v[i].y += pv.y; v[i].z += pv.z; v[i].w += pv.w;
          }
        float4* xo = (float4*)(P.out + (size_t)r * 1024);
#pragma unroll
        for (int i = 0; i < 4; ++i) xo[lane + 64 * i] = v[i];
      }
      float ss = 0.f;
#pragma unroll
      for (int i = 0; i < 4; ++i) ss += v[i].x * v[i].x + v[i].y * v[i].y + v[i].z * v[i].z + v[i].w * v[i].w;
      ss = wsum(ss);
      const float rs = rsqrtf(ss * (1.f / 1024.f) + 1e-6f);
#pragma unroll
      for (int i = 0; i < 4; ++i) {
        float4 gg = ((const float4*)g)[lane + 64 * i];
        uint2 w; w.x = pk2(v[i].x * rs * gg.x, v[i].y * rs * gg.y); w.y = pk2(v[i].z * rs * gg.z, v[i].w * rs * gg.w);
        *(uint2*)(hb + (size_t)r * 1024 + (lane + 64 * i) * 4) = w;
      }
#pragma unroll
      for (int i = 0; i < 4; ++i) v[i] = nv[i];
    }
  }
  if (layer == 0) {
    const float4* xs4 = (const float4*)P.in[1];
    float4* xo4 = (float4*)(P.out + (size_t)TP * 1024);
    for (int e = blockIdx.x * 256 + tid; e < 128 * 256; e += gridDim.x * 256) xo4[e] = xs4[e];
  }
  float* T = (float*)lds;
  const float* win = P.in[10] + (size_t)layer * 1024 * 3736;
  const float* wout = P.in[38] + (size_t)layer * 1024 * 1024;
  const float* wglu = P.in[22] + (size_t)layer * 256 * 256;
  const float* ww2 = P.in[30] + (size_t)layer * 64 * 256;
  const float* wa2 = P.in[32] + (size_t)layer * 64 * 256;
  for (int u = blockIdx.x; u < 960 + 256 + 16 + 4 + 4; u += gridDim.x) {
    if (u < 960) tr_tile(win, 3736, 3736, (u16*)(P.ws + W_WIN), 1024, (u & 15) * 64, (u >> 4) * 64, T);
    else if (u < 1216) { int v = u - 960; tr_tile(wout, 1024, 1024, (u16*)(P.ws + W_WOUT), 1024, (v & 15) * 64, (v >> 4) * 64, T); }
    else if (u < 1232) { int v = u - 1216; tr_tile(wglu, 256, 256, (u16*)(P.ws + W_WGLU), 256, (v & 3) * 64, (v >> 2) * 64, T); }
    else if (u < 1236) { int v = u - 1232; tr_tile(ww2, 256, 256, (u16*)(P.ws + W_WW2), 64, 0, v * 64, T); }
    else { int v = u - 1236; tr_tile(wa2, 256, 256, (u16*)(P.ws + W_WA2), 64, 0, v * 64, T); }
  }
  {
    const int gsz = gridDim.x * 256;
    float* sp = (float*)(P.ws + W_S5P);
    u16* bbt = (u16*)(P.ws + W_S5P + 16384);
    u16* cmt = bbt + 16 * 128 * 16;
    for (int e = blockIdx.x * 256 + tid; e < 16384; e += gsz) {
      const int it = e >> 4, c = e & 15;
      const int gq = it >> 6, p = it & 63;
      const float lr = P.in[14][layer * 1024 + it], li = P.in[15][layer * 1024 + it];
      const float step = expf(P.in[16][layer * 16 + gq]);
      const float br = P.in[17][((size_t)layer * 1024 + it) * 16 + c], bi = P.in[18][((size_t)layer * 1024 + it) * 16 + c];
      const float cre = P.in[19][(((size_t)layer * 16 + gq) * 16 + c) * 64 + p];
      const float cim = P.in[20][(((size_t)layer * 16 + gq) * 16 + c) * 64 + p];
      const float mag = expf(lr * step);
      const float ar = mag * cosf(li * step), ai = mag * sinf(li * step);
      const float den = lr * lr + li * li;
      const float zr = ((ar - 1.f) * lr + ai * li) / den, zi = (ai * lr - (ar - 1.f) * li) / den;
      if (c == 0) {
        sp[it] = ar; sp[1024 + it] = ai;
        float pr = ar, pi = ai;
        for (int s2 = 0; s2 < 6; ++s2) { const float nr = pr * pr - pi * pi, ni = 2.f * pr * pi; pr = nr; pi = ni; }
        sp[2048 + it] = pr; sp[3072 + it] = pi;
      }
      bbt[(gq * 128 + p) * 16 + c] = f2bf(zr * br - zi * bi);
      bbt[(gq * 128 + 64 + p) * 16 + c] = f2bf(zr * bi + zi * br);
      cmt[(gq * 16 + c) * 128 + p] = f2bf(cre);
      cmt[(gq * 16 + c) * 128 + 64 + p] = f2bf(-cim);
    }
  }
}

DI void gemm_tile(const Params& P, int layer, const u16* A, const u16* Bt, int m0, int n0, int mode, int kt0, int nk, char* lds) {
  u16* As = (u16*)lds; u16* Bs = As + 128 * 72;
  int tid_ = threadIdx.x; asm volatile("" : "+v"(tid_));
  const int tid = tid_, wave = tid >> 6, lane = tid & 63, l16 = lane & 15, g4 = lane >> 4;
  const int wm = wave >> 1, wn = wave & 1;
  f32x4 acc[4][4];
#pragma unroll
  for (int i = 0; i < 4; ++i)
#pragma unroll
    for (int j = 0; j < 4; ++j) acc[i][j] = (f32x4){0.f, 0.f, 0.f, 0.f};
  uint4 ra0, ra1, ra2, ra3, rb0, rb1, rb2, rb3;
  const int lrow = tid >> 3, lc8 = (tid & 7) * 8;
  const u16* Ap = A + (size_t)(m0 + lrow) * 1024 + lc8 + kt0 * 64;
  const u16* Bp = Bt + (size_t)(n0 + lrow) * 1024 + lc8 + kt0 * 64;
#define G_LOAD(kt)                                                      \
  ra0 = *(const uint4*)(Ap + (kt) * 64); ra1 = *(const uint4*)(Ap + 32 * 1024 + (kt) * 64);           \
  ra2 = *(const uint4*)(Ap + 64 * 1024 + (kt) * 64); ra3 = *(const uint4*)(Ap + 96 * 1024 + (kt) * 64); \
  rb0 = *(const uint4*)(Bp + (kt) * 64); rb1 = *(const uint4*)(Bp + 32 * 1024 + (kt) * 64);           \
  rb2 = *(const uint4*)(Bp + 64 * 1024 + (kt) * 64); rb3 = *(const uint4*)(Bp + 96 * 1024 + (kt) * 64);
#define G_STORE(st)                                                     \
  { u16* as_ = As + (st) * 2 * 128 * 72; u16* bs_ = Bs + (st) * 2 * 128 * 72;                           \
    *(uint4*)(as_ + lrow * 72 + lc8) = ra0; *(uint4*)(as_ + (lrow + 32) * 72 + lc8) = ra1;             \
    *(uint4*)(as_ + (lrow + 64) * 72 + lc8) = ra2; *(uint4*)(as_ + (lrow + 96) * 72 + lc8) = ra3;      \
    *(uint4*)(bs_ + lrow * 72 + lc8) = rb0; *(uint4*)(bs_ + (lrow + 32) * 72 + lc8) = rb1;             \
    *(uint4*)(bs_ + (lrow + 64) * 72 + lc8) = rb2; *(uint4*)(bs_ + (lrow + 96) * 72 + lc8) = rb3; }
  G_LOAD(0);
  __syncthreads();
  G_STORE(0);
  if (nk > 1) { G_LOAD(1); }
  __syncthreads();
  for (int kt = 0; kt < nk; ++kt) {
    const int cur = kt & 1;
    const u16* as_ = As + cur * 2 * 128 * 72; const u16* bs_ = Bs + cur * 2 * 128 * 72;
#pragma unroll
    for (int ks = 0; ks < 2; ++ks) {
      bf16x8 a[4], b[4];
#pragma unroll
      for (int mt = 0; mt < 4; ++mt) a[mt] = *(const bf16x8*)(as_ + (wm * 64 + mt * 16 + l16) * 72 + ks * 32 + g4 * 8);
#pragma unroll
      for (int nt = 0; nt < 4; ++nt) b[nt] = *(const bf16x8*)(bs_ + (wn * 64 + nt * 16 + l16) * 72 + ks * 32 + g4 * 8);
#pragma unroll
      for (int mt = 0; mt < 4; ++mt)
#pragma unroll
        for (int nt = 0; nt < 4; ++nt) acc[mt][nt] = MFMA16(a[mt], b[nt], acc[mt][nt]);
    }
    if (kt + 1 < nk) {
      G_STORE(cur ^ 1);
      if (kt + 2 < nk) { G_LOAD(kt + 2); }
    }
    __syncthreads();
  }
#undef G_LOAD
#undef G_STORE
  if (mode == 0) {
    u16* proj = (u16*)(P.ws + W_PROJ);
#pragma unroll
    for (int mt = 0; mt < 4; ++mt)
#pragma unroll
      for (int nt = 0; nt < 4; ++nt) {
        const int col = n0 + wn * 64 + nt * 16 + l16;
        if (col < PSTR) {
#pragma unroll
          for (int i = 0; i < 4; ++i) {
            const int row = m0 + wm * 64 + mt * 16 + 4 * g4 + i;
            proj[(size_t)row * PSTR + col] = f2bf(acc[mt][nt][i]);
          }
        }
      }
  } else if (mode == 1) {
#pragma unroll
    for (int mt = 0; mt < 4; ++mt)
#pragma unroll
      for (int i = 0; i < 4; ++i) {
        const int row = m0 + wm * 64 + mt * 16 + 4 * g4 + i;
        const float* xr = xrow(P, layer, row);
#pragma unroll
        for (int nt = 0; nt < 4; ++nt) {
          const int col = n0 + wn * 64 + nt * 16 + l16;
          P.out[(size_t)row * 1024 + col] = xr[col] + acc[mt][nt][i];
        }
      }
  } else {
    float* part = (float*)(P.ws + W_PART) + (size_t)(kt0 >> 2) * 128 * 1024;
#pragma unroll
    for (int mt = 0; mt < 4; ++mt)
#pragma unroll
      for (int i = 0; i < 4; ++i) {
        const int row = m0 - TP + wm * 64 + mt * 16 + 4 * g4 + i;
#pragma unroll
        for (int nt = 0; nt < 4; ++nt) {
          const int col = n0 + wn * 64 + nt * 16 + l16;
          part[(size_t)row * 1024 + col] = acc[mt][nt][i];
        }
      }
  }
}

DI void gemm1_tile(const Params& P, const u16* A, const u16* Bt, int m0, int n0, char* lds) {
  int tid_ = threadIdx.x; asm volatile("" : "+v"(tid_));
  const int tid = tid_, wave = tid >> 6, lane = tid & 63, l16 = lane & 15, g4 = lane >> 4;
  const int wm = wave >> 1, wn = wave & 1;
  f32x4 acc[4][8];
#pragma unroll
  for (int i = 0; i < 4; ++i)
#pragma unroll
    for (int j = 0; j < 8; ++j) acc[i][j] = (f32x4){0.f, 0.f, 0.f, 0.f};
  uint4 ra0, ra1, rb0, rb1, rb2, rb3;
  const int lrow = tid >> 2, lc8 = (tid & 3) * 8;
  const u16* Ap = A + (size_t)(m0 + lrow) * 1024 + lc8;
  const u16* Bp = Bt + (size_t)(n0 + lrow) * 1024 + lc8;
#define H_LOAD(kt)                                                                                      \
  ra0 = *(const uint4*)(Ap + (kt) * 32); ra1 = *(const uint4*)(Ap + 64 * 1024 + (kt) * 32);             \
  rb0 = *(const uint4*)(Bp + (kt) * 32); rb1 = *(const uint4*)(Bp + 64 * 1024 + (kt) * 32);             \
  rb2 = *(const uint4*)(Bp + 128 * 1024 + (kt) * 32); rb3 = *(const uint4*)(Bp + 192 * 1024 + (kt) * 32);
#define H_STORE(st)                                                                                     \
  { u16* as_ = (u16*)(lds + (st) * 30720); u16* bs_ = as_ + 128 * 40;                                    \
    *(uint4*)(as_ + lrow * 40 + lc8) = ra0; *(uint4*)(as_ + (lrow + 64) * 40 + lc8) = ra1;              \
    *(uint4*)(bs_ + lrow * 40 + lc8) = rb0; *(uint4*)(bs_ + (lrow + 64) * 40 + lc8) = rb1;              \
    *(uint4*)(bs_ + (lrow + 128) * 40 + lc8) = rb2; *(uint4*)(bs_ + (lrow + 192) * 40 + lc8) = rb3; }
#define H_COMPUTE(st)                                                                                   \
  { const u16* as_ = (const u16*)(lds + (st) * 30720); const u16* bs_ = as_ + 128 * 40;                  \
    bf16x8 a[4], b[8];                                                                                  \
    _Pragma("unroll") for (int mt = 0; mt < 4; ++mt) a[mt] = *(const bf16x8*)(as_ + (wm * 64 + mt * 16 + l16) * 40 + g4 * 8);   \
    _Pragma("unroll") for (int nt = 0; nt < 8; ++nt) b[nt] = *(const bf16x8*)(bs_ + (wn * 128 + nt * 16 + l16) * 40 + g4 * 8);  \
    _Pragma("unroll") for (int mt = 0; mt < 4; ++mt) _Pragma("unroll") for (int nt = 0; nt < 8; ++nt)     \
      acc[mt][nt] = MFMA16(a[mt], b[nt], acc[mt][nt]); }
  H_LOAD(0);
  __syncthreads();
  H_STORE(0);
  H_LOAD(1);
  __syncthreads();
  for (int kt = 0; kt < 32; kt += 2) {
    H_COMPUTE(0);
    H_STORE(1);
    if (kt + 2 < 32) { H_LOAD(kt + 2); }
    __syncthreads();
    H_COMPUTE(1);
    if (kt + 2 < 32) {
      H_STORE(0);
      H_LOAD(kt + 3);
    }
    __syncthreads();
  }
#undef H_LOAD
#undef H_STORE
#undef H_COMPUTE
  u16* proj = (u16*)(P.ws + W_PROJ);
#pragma unroll
  for (int mt = 0; mt < 4; ++mt)
#pragma unroll
    for (int nt = 0; nt < 8; ++nt) {
      const int col = n0 + wn * 128 + nt * 16 + l16;
      if (col < PSTR) {
#pragma unroll
        for (int i = 0; i < 4; ++i) {
          const int row = m0 + wm * 64 + mt * 16 + 4 * g4 + i;
          proj[(size_t)row * PSTR + col] = f2bf(acc[mt][nt][i]);
        }
      }
    }
}

DI void phase_gemm1(const Params& P, int layer, char* lds) {
  const u16* A = (const u16*)(P.ws + W_HB);
  const u16* Bt = (const u16*)(P.ws + W_WIN);
  const int x = blockIdx.x & 7, j = blockIdx.x >> 3, nloc = gridDim.x >> 3;
  for (int t = j; t < 240; t += nloc) {
    const int mg = t / 120, rem = t - mg * 120;
    gemm1_tile(P, A, Bt, (x * 16 + mg * 8 + (rem & 7)) * 128, (rem >> 3) * 256, lds);
  }
  const int base = 240 % nloc;
  for (int e = 0; e < 2; ++e) {
    const int n = x + 8 * e;
    if (n < 15 && j == (base + e) % nloc) gemm1_tile(P, A, Bt, TP, n * 256, lds);
  }
}
DI void phase_gemm2(const Params& P, int layer, char* lds) {
  const u16* A = (const u16*)(P.ws + W_HB);
  const u16* Bt = (const u16*)(P.ws + W_WOUT);
  const int x = blockIdx.x & 7, j = blockIdx.x >> 3, nloc = gridDim.x >> 3;
  for (int t = j; t < 128; t += nloc) gemm_tile(P, layer, A, Bt, (x * 16 + (t >> 3)) * 128, (t & 7) * 128, 1, 0, 16, lds);
  const int base = 128 % nloc;
  for (int e = 0; e < 4; ++e) {
    const int v = x * 4 + e;
    if (j == (base + e) % nloc) gemm_tile(P, layer, A, Bt, TP, (v & 7) * 128, 2, (v >> 3) * 4, 4, lds);
  }
}

DI void epi_row(const Params& P, int layer, int m, int h, int tok, int q, const float* o, const u16* prevrow,
                const float* prevf, float bonus, bool active) {
  float s = 0.f, ss = 0.f;
#pragma unroll
  for (int j = 0; j < 16; ++j) { s += o[j]; ss += o[j] * o[j]; }
  s = qsum(s); ss = qsum(ss);
  if (!active) return;
  const u16* prow = (const u16*)(P.ws + W_PROJ) + (size_t)tok * PSTR;
  const int col0 = h * 64 + 16 * q;
  const int gcol = (m == 0 ? C_GLA_GATE : (m == 1 ? C_GDN_GATE : C_RW_GATE)) + col0;
  u16* mixed = (u16*)(P.ws + W_HB) + (size_t)tok * 1024 + (m == 0 ? 0 : (m == 1 ? 512 : 768)) + col0;
  const float mu = s * (1.f / 64.f);
  const float r = (m < 2) ? rsqrtf(ss * (1.f / 64.f) + 1e-6f) : rsqrtf(fmaxf(ss * (1.f / 64.f) - mu * mu, 0.f) + 64e-5f);
  const float* gn0 = opq(P.in[13]); const float* gn1 = opq(P.in[27]);
  const float* gn = (m == 0 ? gn0 : gn1) + layer * 64 + 16 * q;
  const float* lng = P.in[36] + layer * 256 + col0;
  const float* lnb = P.in[37] + layer * 256 + col0;
  const float* muv = P.in[28] + layer * 896 + 512 + col0;
#pragma unroll
  for (int c4 = 0; c4 < 4; ++c4) {
    float outv[4];
    const uint2 gw = *(const uint2*)(prow + gcol + 4 * c4);
    float gate[4];
    gate[0] = __uint_as_float(gw.x << 16); gate[1] = __uint_as_float(gw.x & 0xffff0000u);
    gate[2] = __uint_as_float(gw.y << 16); gate[3] = __uint_as_float(gw.y & 0xffff0000u);
    if (m < 2) {
#pragma unroll
      for (int j = 0; j < 4; ++j) outv[j] = o[4 * c4 + j] * r * gn[4 * c4 + j] * silu(gate[j]);
    } else {
      const uint2 xw = *(const uint2*)(prow + C_RW_V + col0 + 4 * c4);
      float xv[4], pv[4];
      xv[0] = __uint_as_float(xw.x << 16); xv[1] = __uint_as_float(xw.x & 0xffff0000u);
      xv[2] = __uint_as_float(xw.y << 16); xv[3] = __uint_as_float(xw.y & 0xffff0000u);
      if (prevf) {
#pragma unroll
        for (int j = 0; j < 4; ++j) pv[j] = prevf[512 + col0 + 4 * c4 + j];
      } else if (prevrow) {
        const uint2 pw = *(const uint2*)(prevrow + C_RW_V + col0 + 4 * c4);
        pv[0] = __uint_as_float(pw.x << 16); pv[1] = __uint_as_float(pw.x & 0xffff0000u);
        pv[2] = __uint_as_float(pw.y << 16); pv[3] = __uint_as_float(pw.y & 0xffff0000u);
      } else {
#pragma unroll
        for (int j = 0; j < 4; ++j) pv[j] = 0.f;
      }
#pragma unroll
      for (int j = 0; j < 4; ++j) {
        const float vs = xv[j] + (pv[j] - xv[j]) * muv[4 * c4 + j];
        outv[j] = ((o[4 * c4 + j] - mu) * r * lng[4 * c4 + j] + lnb[4 * c4 + j] + bonus * vs) * silu(gate[j]);
      }
    }
    uint2 w; w.x = pk2(outv[0], outv[1]); w.y = pk2(outv[2], outv[3]);
    *(uint2*)(mixed + 4 * c4) = w;
    __builtin_amdgcn_sched_barrier(0);
  }
}

DI int tix(int r, int c) { return r * 64 + (c ^ ((r & 7) << 3)); }
DI void st16t(u16* tile, int r, int c, const float* v) {
  uint4 a, b;
  a.x = pk2(v[0], v[1]); a.y = pk2(v[2], v[3]); a.z = pk2(v[4], v[5]); a.w = pk2(v[6], v[7]);
  b.x = pk2(v[8], v[9]); b.y = pk2(v[10], v[11]); b.z = pk2(v[12], v[13]); b.w = pk2(v[14], v[15]);
  *(uint4*)(tile + tix(r, c)) = a; *(uint4*)(tile + tix(r, c + 8)) = b;
}
DI void mm64(f32x4* acc, const u16* A, const u16* Bt, int wave, int l16, int g4) {
#pragma unroll
  for (int ks = 0; ks < 2; ++ks) {
    bf16x8 a = *(const bf16x8*)(A + tix(wave * 16 + l16, ks * 32 + g4 * 8));
#pragma unroll
    for (int nt = 0; nt < 4; ++nt) {
      bf16x8 b = *(const bf16x8*)(Bt + tix(nt * 16 + l16, ks * 32 + g4 * 8));
      acc[nt] = MFMA16(a, b, acc[nt]);
    }
  }
}
DI void zero4(f32x4* a) {
#pragma unroll
  for (int i = 0; i < 4; ++i) a[i] = (f32x4){0.f, 0.f, 0.f, 0.f};
}

struct RowCtx {
  const u16* prow;
  int npast;
  const float* cst;
  const float* sst;
  bool valid;
};

DI void mix_unit(const Params& P, int layer, int m, int kind, int bs, int h, int c, char* lds) {
  int tid_ = threadIdx.x; asm volatile("" : "+v"(tid_));
  const int tid = tid_, wave = tid >> 6, lane = tid & 63, l16 = lane & 15, g4 = lane >> 4;
  const int t = tid >> 2, q = tid & 3;
  u16* R0 = (u16*)lds; u16* R1 = R0 + 4096; u16* R2 = R0 + 2 * 4096; u16* R3 = R0 + 3 * 4096;
  u16* R4 = R0 + 4 * 4096; u16* R5 = R0 + 5 * 4096; u16* R6 = R0 + 6 * 4096;
  float* F0 = (float*)(lds + 57344);
  float* SM = (float*)(lds + 73728);
  const u16* proj = (const u16*)(P.ws + W_PROJ);

  RowCtx R;
  int tok;
  if (kind == 0) {
    tok = bs * 2048 + c * 64 + t;
    R.prow = proj + (size_t)tok * PSTR; R.npast = c * 64 + t; R.cst = nullptr; R.sst = nullptr; R.valid = true;
  } else {
    tok = TP + bs;
    R.prow = proj + (size_t)tok * PSTR; R.npast = 0;
    R.cst = P.in[6] + ((size_t)layer * 128 + bs) * 2304;
    R.sst = P.in[8] + ((size_t)layer * 128 + bs) * 896;
    R.valid = (t == 0);
  }
  float al[16], be[16], kr[16], qv[16], vv[16], ld[16];
  float sst16[16];
#pragma unroll
  for (int i = 0; i < 16; ++i) sst16[i] = 0.f;
  if (kind == 1) {
    const int kq = wave, v = lane;
    const size_t sbase = ((size_t)(layer * 128 + bs) * 4 + h) * 4096;
    const float* si0 = opq(P.in[2]); const float* si1 = opq(P.in[5]); const float* si2 = opq(P.in[7]);
    const float* sin = (m == 0 ? si0 : (m == 1 ? si1 : si2)) + sbase;
    if (m == 2) {
#pragma unroll
      for (int i = 0; i < 4; ++i) {
        float4 x = *(const float4*)(sin + v * 64 + 16 * kq + 4 * i);
        sst16[4 * i] = x.x; sst16[4 * i + 1] = x.y; sst16[4 * i + 2] = x.z; sst16[4 * i + 3] = x.w;
      }
    } else {
#pragma unroll
      for (int i = 0; i < 16; ++i) sst16[i] = sin[(16 * kq + i) * 64 + v];
    }
  }
  float gtok = 0.f, bonus = 0.f;
#pragma unroll
  for (int j = 0; j < 16; ++j) { al[j] = 0.f; be[j] = 0.f; kr[j] = 0.f; qv[j] = 0.f; vv[j] = 0.f; ld[j] = 0.f; }
  const int d0 = h * 64 + 16 * q;

  if (m == 0) {
    if (R.valid) {
      float kk[16], glr[16];
      ld16(R.prow + C_GLA_Q + d0, qv); ld16(R.prow + C_GLA_K + d0, kk); ld16(R.prow + C_GLA_V + d0, vv);
      ld16(R.prow + C_GLA_GLR, glr);
      float x[16];
      const float* bg = P.in[12] + layer * 256 + d0;
      const float* wg = P.in[11] + (size_t)layer * 16 * 256 + d0;
#pragma unroll
      for (int j = 0; j < 16; ++j) x[j] = bg[j];
#pragma unroll
      for (int r = 0; r < 16; ++r) {
#pragma unroll
        for (int j = 0; j < 16; ++j) x[j] += glr[r] * wg[r * 256 + j];
        if ((r & 7) == 7) __builtin_amdgcn_sched_barrier(0);
      }
#pragma unroll
      for (int j = 0; j < 16; ++j) { ld[j] = -softplus(-x[j]) * (1.f / 16.f); kr[j] = kk[j]; qv[j] *= 0.125f; }
    }
  } else if (m == 1) {
    float a_raw = 0.f, b_raw = 0.f;
    float* cwL = (float*)R6;
    for (int e = tid; e < 768; e += 256) {
      const int part = e >> 8, tap = (e >> 6) & 3, d = e & 63;
      cwL[e] = P.in[24][(size_t)layer * 3072 + tap * 768 + part * 256 + h * 64 + d];
    }
    __syncthreads();
    if (R.valid) {
      uint4 xr[3][4][2];
      if (!R.cst) {
#pragma unroll
        for (int part = 0; part < 3; ++part)
#pragma unroll
          for (int jj = 0; jj < 4; ++jj) {
            const bool ok = R.npast >= jj;
            const u16* pp = R.prow - (size_t)(ok ? jj : 0) * PSTR + C_GDN_Q + part * 256 + d0;
            uint4 v0 = *(const uint4*)pp, v1 = *(const uint4*)(pp + 8);
            if (!ok) { v0 = make_uint4(0, 0, 0, 0); v1 = v0; }
            xr[part][jj][0] = v0; xr[part][jj][1] = v1;
          }
      }
      a_raw = bf2f(R.prow[C_GDN_A + h]); b_raw = bf2f(R.prow[C_GDN_B + h]);
#pragma unroll
      for (int part = 0; part < 3; ++part) {
        const int colrel = part * 256 + d0;
        const float* cw = cwL + part * 256 + 16 * q;
        float acc[16];
        if (R.cst) {
          float x[16];
          ld16(R.prow + C_GDN_Q + colrel, x);
#pragma unroll
          for (int j = 0; j < 16; ++j) acc[j] = x[j] * cw[3 * 64 + j];
#pragma unroll
          for (int jj = 1; jj <= 3; ++jj) {
            const float* sp_ = R.cst + (3 - jj) * 768 + colrel;
#pragma unroll
            for (int j = 0; j < 16; ++j) acc[j] += sp_[j] * cw[(3 - jj) * 64 + j];
          }
        } else {
#pragma unroll
          for (int j = 0; j < 16; ++j) acc[j] = 0.f;
#pragma unroll
          for (int jj = 0; jj < 4; ++jj) {
            float x[16];
            unpk8(xr[part][jj][0], x); unpk8(xr[part][jj][1], x + 8);
#pragma unroll
            for (int j = 0; j < 16; ++j) acc[j] += x[j] * cw[(3 - jj) * 64 + j];
          }
        }
        __builtin_amdgcn_sched_barrier(0);
#pragma unroll
        for (int j = 0; j < 16; ++j) {
          const float sv = silu(acc[j]);
          if (part == 0) qv[j] = sv; else if (part == 1) al[j] = sv; else vv[j] = sv;
        }
      }
      a_raw = bf2f(R.prow[C_GDN_A + h]); b_raw = bf2f(R.prow[C_GDN_B + h]);
    }
    float sq = 0.f, sk = 0.f;
#pragma unroll
    for (int j = 0; j < 16; ++j) { sq += qv[j] * qv[j]; sk += al[j] * al[j]; }
    sq = qsum(sq); sk = qsum(sk);
    if (R.valid) {
      const float rq = rsqrtf(sq + 1e-6f) * 0.125f, rk = rsqrtf(sk + 1e-6f);
      const float gg = -__expf(P.in[25][layer * 4 + h]) * softplus(a_raw + P.in[26][layer * 4 + h]);
      const float beta = sigm(b_raw);
      const float eg = __expf(gg);
      gtok = gg;
#pragma unroll
      for (int j = 0; j < 16; ++j) {
        const float k = al[j] * rk;
        al[j] = k; be[j] = -eg * beta * k; kr[j] = beta * k; qv[j] *= rq;
      }
    }
  } else {
    const float* mu = P.in[28] + layer * 896;
    uint4 hx[3][2], hp[3][2];
#pragma unroll
    for (int part = 0; part < 3; ++part) {
      const bool okp = R.valid && !R.sst && R.npast >= 1;
      const u16* pc = R.prow + C_RW_R + part * 256 + d0;
      const u16* pq = pc - (okp ? PSTR : 0);
      uint4 c0 = *(const uint4*)pc, c1 = *(const uint4*)(pc + 8), p0 = *(const uint4*)pq, p1 = *(const uint4*)(pq + 8);
      if (!okp) { p0 = make_uint4(0, 0, 0, 0); p1 = p0; }
      hx[part][0] = c0; hx[part][1] = c1; hp[part][0] = p0; hp[part][1] = p1;
    }
    {
      float tw[16], ta[16];
#pragma unroll
      for (int j = 0; j < 16; ++j) { tw[j] = 0.f; ta[j] = 0.f; }
      if (R.valid) {
#pragma unroll
        for (int part = 3; part < 5; ++part) {
          const int colrel = (part == 3 ? 768 + 16 * q : 832 + 16 * q);
          float x[16], pv[16];
          ld16(R.prow + C_RW_R + colrel, x);
          if (R.sst) {
#pragma unroll
            for (int j = 0; j < 16; ++j) pv[j] = R.sst[colrel + j];
          } else if (R.npast >= 1) ld16(R.prow - PSTR + C_RW_R + colrel, pv);
          else {
#pragma unroll
            for (int j = 0; j < 16; ++j) pv[j] = 0.f;
          }
#pragma unroll
          for (int j = 0; j < 16; ++j) {
            const float xs = x[j] + (pv[j] - x[j]) * mu[colrel + j];
            if (part == 3) tw[j] = ftanh(xs); else ta[j] = xs;
          }
        }
      }
      st16t(R0, t, 16 * q, tw);
      st16t(R1, t, 16 * q, ta);
    }
    {
      const u16* w2 = (const u16*)(P.ws + W_WW2) + (size_t)(h * 64 + t) * 64 + 16 * q;
      const u16* a2 = (const u16*)(P.ws + W_WA2) + (size_t)(h * 64 + t) * 64 + 16 * q;
      *(uint4*)(R2 + tix(t, 16 * q)) = *(const uint4*)w2; *(uint4*)(R2 + tix(t, 16 * q + 8)) = *(const uint4*)(w2 + 8);
      *(uint4*)(R3 + tix(t, 16 * q)) = *(const uint4*)a2; *(uint4*)(R3 + tix(t, 16 * q + 8)) = *(const uint4*)(a2 + 8);
    }
    __syncthreads();
    {
      f32x4 aw[4], aa[4];
      zero4(aw); zero4(aa);
      mm64(aw, R0, R2, wave, l16, g4);
      mm64(aa, R1, R3, wave, l16, g4);
      float* FA = (float*)R4;
#pragma unroll
      for (int nt = 0; nt < 4; ++nt)
#pragma unroll
        for (int i = 0; i < 4; ++i) {
          const int row = wave * 16 + 4 * g4 + i, col = nt * 16 + l16;
          F0[row * 64 + col] = aw[nt][i]; FA[row * 64 + col] = aa[nt][i];
        }
    }
    __syncthreads();
    float av[16];
    {
      const float* FA = (const float*)R4;
      const float* w0 = P.in[29] + layer * 256 + d0;
      const float* a0 = P.in[31] + layer * 256 + d0;
#pragma unroll
      for (int j = 0; j < 16; ++j) {
        const float wraw = -softplus(-(w0[j] + F0[t * 64 + 16 * q + j])) - 0.5f;
        ld[j] = -__expf(wraw);
        av[j] = sigm(a0[j] + FA[t * 64 + 16 * q + j]);
      }
    }
    __syncthreads();
    float skk = 0.f, sb = 0.f;
    if (R.valid) {
#pragma unroll
      for (int part = 0; part < 3; ++part) {
        const int colrel = part * 256 + d0;
        float x[16], pv[16];
        unpk8(hx[part][0], x); unpk8(hx[part][1], x + 8);
        if (R.sst) {
#pragma unroll
          for (int j = 0; j < 16; ++j) pv[j] = R.sst[colrel + j];
        } else { unpk8(hp[part][0], pv); unpk8(hp[part][1], pv + 8); }
#pragma unroll
        for (int j = 0; j < 16; ++j) {
          const float xs = x[j] + (pv[j] - x[j]) * mu[colrel + j];
          if (part == 0) qv[j] = xs; else if (part == 1) kr[j] = xs; else vv[j] = xs;
        }
      }
      const float* kkw = P.in[33] + layer * 256 + d0;
      const float* kaw = P.in[34] + layer * 256 + d0;
      const float* rkw = P.in[35] + layer * 256 + d0;
#pragma unroll
      for (int j = 0; j < 16; ++j) {
        al[j] = kr[j] * kkw[j];
        skk += al[j] * al[j];
        kr[j] = kr[j] * (1.f + (av[j] - 1.f) * kaw[j]);
        sb += qv[j] * kr[j] * rkw[j];
      }
    }
    skk = qsum(skk); sb = qsum(sb);
    if (R.valid) {
      const float rn = rsqrtf(skk + 1e-6f);
      bonus = sb;
#pragma unroll
      for (int j = 0; j < 16; ++j) { al[j] *= rn; be[j] = -(al[j] * av[j]); }
    } else {
#pragma unroll
      for (int j = 0; j < 16; ++j) ld[j] = 0.f;
    }
  }

  const bool delta = (m != 0), modeS = (m == 1);

  if (kind == 1) {
    float* vec = F0;
    float* red = F0 + 512;
    float* red2 = F0 + 768;
    float* Ov = F0 + 1024;
    if (t == 0) {
#pragma unroll
      for (int j = 0; j < 16; ++j) {
        const int d = 16 * q + j;
        vec[d] = al[j]; vec[64 + d] = be[j]; vec[128 + d] = kr[j]; vec[192 + d] = qv[j]; vec[256 + d] = vv[j];
        vec[320 + d] = modeS ? __expf(gtok) : __expf(ld[j]);
      }
    }
    __syncthreads();
    const int kq = wave, v = lane;
    const size_t sbase = ((size_t)(layer * 128 + bs) * 4 + h) * 4096;
    float* sout = P.out + (m == 0 ? O_GLA_S : (m == 1 ? O_GDN_S : O_RW_S)) + sbase;
    float s[16];
#pragma unroll
    for (int i = 0; i < 16; ++i) s[i] = sst16[i];
    float zp = 0.f;
#pragma unroll
    for (int i = 0; i < 16; ++i) zp += vec[16 * kq + i] * s[i];
    red[kq * 64 + v] = zp;
    __syncthreads();
    const float z = red[v] + red[64 + v] + red[128 + v] + red[192 + v];
    const float vval = vec[256 + v];
    float op = 0.f;
#pragma unroll
    for (int i = 0; i < 16; ++i) {
      const int k = 16 * kq + i;
      s[i] = vec[320 + k] * s[i] + vec[64 + k] * z + vec[128 + k] * vval;
      op += vec[192 + k] * s[i];
    }
    red2[kq * 64 + v] = op;
    if (m == 2) {
#pragma unroll
      for (int i = 0; i < 4; ++i)
        *(float4*)(sout + v * 64 + 16 * kq + 4 * i) = make_float4(s[4 * i], s[4 * i + 1], s[4 * i + 2], s[4 * i + 3]);
    } else {
#pragma unroll
      for (int i = 0; i < 16; ++i) sout[(16 * kq + i) * 64 + v] = s[i];
    }
    __syncthreads();
    if (tid < 64) Ov[tid] = red2[tid] + red2[64 + tid] + red2[128 + tid] + red2[192 + tid];
    __syncthreads();
    float o[16];
#pragma unroll
    for (int j = 0; j < 16; ++j) o[j] = Ov[16 * q + j];
    epi_row(P, layer, m, h, tok, q, o, nullptr, R.sst, bonus, t == 0);
    if (h == 0 && m == 1) {
      float* co = P.out + O_CONV_S + ((size_t)layer * 128 + bs) * 2304;
      for (int e = tid; e < 2304; e += 256) {
        const int rrow = e / 768, cc = e % 768;
        co[e] = rrow < 2 ? R.cst[(rrow + 1) * 768 + cc] : bf2f(R.prow[C_GDN_Q + cc]);
      }
    }
    if (h == 0 && m == 2) {
      float* so = P.out + O_SH_S + ((size_t)layer * 128 + bs) * 896;
      for (int e = tid; e < 896; e += 256) so[e] = bf2f(R.prow[C_RW_R + e]);
    }
    __syncthreads();
    return;
  }

  const int u1 = (bs * 4 + h) * 32 + c;
  u16* tb = (u16*)(P.ws + W_TILES) + (size_t)(m == 0 ? u1 * 3 : 3072 + (m - 1) * 4096 + u1 * 4) * 4096;
  float* aux = (float*)(P.ws + W_AUX) + (size_t)(m * 1024 + u1) * 128;
  unsigned khat[8], bhat[8];
  float rowR = 1.f;
  {
    float bh16[16];
    if (!modeS) {
#pragma unroll
      for (int j = 0; j < 16; ++j) F0[t * 64 + 16 * q + j] = ld[j];
      __syncthreads();
      {
        const int d = tid & 63, seg = tid >> 6;
        float sacc = 0.f;
        for (int tt = 0; tt < 16; ++tt) { sacc += F0[(seg * 16 + tt) * 64 + d]; F0[(seg * 16 + tt) * 64 + d] = sacc; }
        SM[seg * 64 + d] = sacc;
      }
      __syncthreads();
      const int seg = t >> 4;
#pragma unroll
      for (int j = 0; j < 16; ++j) {
        const int d = 16 * q + j;
        const float s0 = SM[d], s1 = SM[64 + d], s2 = SM[128 + d], s3 = SM[192 + d];
        float off = 0.f;
        if (seg > 0) off += s0;
        if (seg > 1) off += s1;
        if (seg > 2) off += s2;
        const float cum = F0[t * 64 + d] + off;
        const float cC = s0 + s1 + s2 + s3;
        const float e1 = __expf(cum - ld[j]), e2 = __expf(-cum), e3 = __expf(cum), e4 = __expf(cC - cum);
        if (t == 0) aux[d] = __expf(cC);
        ld[j] = kr[j] * e4; bh16[j] = be[j] * e4;
        al[j] *= e1; be[j] *= e2; kr[j] *= e2; qv[j] *= e3;
        if ((j & 3) == 3) __builtin_amdgcn_sched_barrier(0);
      }
      __syncthreads();
    } else {
      if (q == 0) SM[t] = gtok;
      __syncthreads();
      float gc = 0.f, gall = 0.f;
      for (int j = 0; j < 64; ++j) { const float x = SM[j]; gall += x; if (j <= t) gc += x; }
      __syncthreads();
      if (q == 0) { SM[64 + t] = gc; SM[128 + t] = gc - gtok; }
      const float ehs = __expf(gall - gc);
      rowR = __expf(gc);
#pragma unroll
      for (int j = 0; j < 16; ++j) { ld[j] = kr[j] * ehs; bh16[j] = be[j] * ehs; }
      if (t == 0) {
        const float rsx = __expf(gall);
#pragma unroll
        for (int j = 0; j < 16; ++j) aux[16 * q + j] = rsx;
      }
    }
#pragma unroll
    for (int j = 0; j < 8; ++j) { khat[j] = pk2(ld[2 * j], ld[2 * j + 1]); bhat[j] = pk2(bh16[2 * j], bh16[2 * j + 1]); }
  }
  if (m == 2 && q == 0) aux[64 + t] = bonus;
  st16t(R3, t, 16 * q, qv);
  {
    float tmp[16];
#pragma unroll
    for (int j = 0; j < 16; ++j) tmp[j] = qv[j] * rowR;
    st16(tb + t * 64 + 16 * q, tmp);
  }
  st16t(R2, t, 16 * q, kr);
  if (delta) { st16t(R0, t, 16 * q, al); st16t(R1, t, 16 * q, be); }
  __syncthreads();
  const float* gcA = SM + 64;
  const float* gxA = SM + 128;
  f32x4 acc[4];
  zero4(acc); mm64(acc, R3, R2, wave, l16, g4);
#pragma unroll
  for (int nt = 0; nt < 4; ++nt)
#pragma unroll
    for (int i = 0; i < 4; ++i) {
      const int row = wave * 16 + 4 * g4 + i, col = nt * 16 + l16;
      float v = acc[nt][i];
      if (modeS) v *= __expf(fminf(gcA[row] - gcA[col], 0.f));
      R6[tix(row, col)] = f2bf(col <= row ? v : 0.f);
    }
  if (delta) {
    zero4(acc); mm64(acc, R0, R1, wave, l16, g4);
#pragma unroll
    for (int nt = 0; nt < 4; ++nt)
#pragma unroll
      for (int i = 0; i < 4; ++i) {
        const int row = wave * 16 + 4 * g4 + i, col = nt * 16 + l16;
        float v = acc[nt][i];
        if (modeS) v *= __expf(fminf(gxA[row] - gcA[col], 0.f));
        F0[col * 64 + row] = col < row ? -v : 0.f;
      }
    zero4(acc); mm64(acc, R0, R2, wave, l16, g4);
#pragma unroll
    for (int nt = 0; nt < 4; ++nt)
#pragma unroll
      for (int i = 0; i < 4; ++i) {
        const int row = wave * 16 + 4 * g4 + i, col = nt * 16 + l16;
        float v = acc[nt][i];
        if (modeS) v *= __expf(fminf(gxA[row] - gcA[col], 0.f));
        R4[tix(row, col)] = f2bf(col < row ? v : 0.f);
      }
    zero4(acc); mm64(acc, R3, R1, wave, l16, g4);
#pragma unroll
    for (int nt = 0; nt < 4; ++nt)
#pragma unroll
      for (int i = 0; i < 4; ++i) {
        const int row = wave * 16 + 4 * g4 + i, col = nt * 16 + l16;
        float v = acc[nt][i];
        if (modeS) v *= __expf(fminf(gcA[row] - gcA[col], 0.f));
        R5[tix(row, col)] = f2bf(col <= row ? v : 0.f);
      }
  }
  __syncthreads();
#pragma unroll
  for (int j = 0; j < 16; ++j) {
    R1[tix(16 * q + j, t)] = f2bf(vv[j]);
    const unsigned w = khat[j >> 1];
    R2[tix(16 * q + j, t)] = (u16)((j & 1) ? (w >> 16) : (w & 0xffffu));
  }
  __syncthreads();
  f32x4 p1[4], p2[4];
  zero4(p1); mm64(p1, R6, R1, wave, l16, g4);
  zero4(p2); mm64(p2, R2, R1, wave, l16, g4);
  if (delta) {
    zero4(acc); mm64(acc, R4, R1, wave, l16, g4);
    __syncthreads();
#pragma unroll
    for (int nt = 0; nt < 4; ++nt)
#pragma unroll
      for (int i = 0; i < 4; ++i) R4[tix(wave * 16 + 4 * g4 + i, nt * 16 + l16)] = f2bf(acc[nt][i]);
#pragma unroll
    for (int j = 0; j < 16; ++j) {
      const unsigned w = bhat[j >> 1];
      R2[tix(16 * q + j, t)] = (u16)((j & 1) ? (w >> 16) : (w & 0xffffu));
    }
    __syncthreads();
    {
      const int colx = tid >> 1, hf = tid & 1;
      const u16* rhs = colx < 64 ? R4 : R0;
      u16* xt = colx < 64 ? R3 : R6;
      const int cc = colx & 63;
      const bool scl = modeS && colx >= 64;
#pragma unroll 1
      for (int ib = 0; ib < 4; ++ib) {
        float sx[16];
#pragma unroll
        for (int r = 0; r < 16; ++r) {
          float x = bf2f(rhs[tix(16 * ib + r, cc)]);
          if (scl) x *= __expf(gxA[16 * ib + r]);
          sx[r] = hf ? 0.f : x;
        }
#pragma unroll 1
        for (int j = 8 * hf; j < 16 * ib; j += 16) {
          float xv[8];
          unpk8(*(const uint4*)(xt + tix(cc, j)), xv);
#pragma unroll
          for (int jj = 0; jj < 8; ++jj) {
            const float4* lt = (const float4*)(F0 + (j + jj) * 64 + 16 * ib);
#pragma unroll
            for (int r4 = 0; r4 < 4; ++r4) {
              const float4 l4 = lt[r4];
              sx[4 * r4] -= l4.x * xv[jj]; sx[4 * r4 + 1] -= l4.y * xv[jj];
              sx[4 * r4 + 2] -= l4.z * xv[jj]; sx[4 * r4 + 3] -= l4.w * xv[jj];
            }
          }
        }
#pragma unroll
        for (int r = 0; r < 16; ++r) sx[r] += __shfl_xor(sx[r], 1);
#pragma unroll
        for (int r2 = 0; r2 < 15; ++r2) {
          const float* lt = F0 + (16 * ib + r2) * 64 + 16 * ib;
#pragma unroll
          for (int r = r2 + 1; r < 16; ++r) sx[r] -= lt[r] * sx[r2];
        }
        if (hf == 0) st16t(xt, cc, 16 * ib, sx);
      }
    }
    __syncthreads();
    zero4(acc); mm64(acc, R5, R6, wave, l16, g4);
#pragma unroll
    for (int nt = 0; nt < 4; ++nt)
#pragma unroll
      for (int i = 0; i < 4; ++i) {
        const int row = wave * 16 + 4 * g4 + i, col = nt * 16 + l16;
        tb[row * 64 + col] = f2bf(acc[nt][i] + bf2f(tb[row * 64 + col]));
      }
    mm64(p1, R5, R3, wave, l16, g4);
    mm64(p2, R2, R3, wave, l16, g4);
    zero4(acc); mm64(acc, R2, R6, wave, l16, g4);
#pragma unroll
    for (int nt = 0; nt < 4; ++nt)
#pragma unroll
      for (int i = 0; i < 4; ++i) tb[12288 + (wave * 16 + 4 * g4 + i) * 64 + nt * 16 + l16] = f2bf(acc[nt][i]);
  }
#pragma unroll
  for (int nt = 0; nt < 4; ++nt)
#pragma unroll
    for (int i = 0; i < 4; ++i) {
      tb[4096 + (wave * 16 + 4 * g4 + i) * 64 + nt * 16 + l16] = f2bf(p1[nt][i]);
      tb[8192 + (wave * 16 + 4 * g4 + i) * 64 + nt * 16 + l16] = f2bf(p2[nt][i]);
    }
  if (c == 31 && h == 0 && m == 1) {
    float* co = P.out + O_CONV_P + ((size_t)layer * 8 + bs) * 2304;
    for (int e = tid; e < 2304; e += 256) {
      const int rrow = e / 768, cc = e % 768;
      co[e] = bf2f(proj[(size_t)(bs * 2048 + 2045 + rrow) * PSTR + C_GDN_Q + cc]);
    }
  }
  if (c == 31 && h == 0 && m == 2) {
    float* so = P.out + O_SH_P + ((size_t)layer * 8 + bs) * 896;
    for (int e = tid; e < 896; e += 256) so[e] = bf2f(proj[(size_t)(bs * 2048 + 2047) * PSTR + C_RW_R + e]);
  }
  __syncthreads();
}

DI void m2_unit(const Params& P, int layer, int m, int b, int h, char* lds) {
  int tid_ = threadIdx.x; asm volatile("" : "+v"(tid_));
  const int tid = tid_, wv = tid >> 6, lane = tid & 63, l16 = lane & 15, g4 = lane >> 4;
  u16* QdT = (u16*)lds; u16* OlT = QdT + 4608; u16* dST = QdT + 2 * 4608; u16* McT = QdT + 3 * 4608;
  float* Ot = (float*)(lds + 36864);
  float* rsA = (float*)(lds + 36864 + 16640);
  const int u0 = (b * 4 + h) * 32;
  const u16* proj = (const u16*)(P.ws + W_PROJ);
  const int lrow = tid >> 3, lc8 = (tid & 7) * 8;
  f32x4 S[4];
  zero4(S);
  uint4 rq0, rq1, ro0, ro1, rd0, rd1, rm0, rm1;
  float rrs = 0.f;
  rm0 = make_uint4(0, 0, 0, 0); rm1 = rm0;
#define M2_GLOAD(cc)                                                                                                  \
  {                                                                                                                   \
    const int u1 = u0 + (cc);                                                                                         \
    const u16* tb = (const u16*)(P.ws + W_TILES) + (size_t)(m == 0 ? u1 * 3 : 3072 + (m - 1) * 4096 + u1 * 4) * 4096 + lrow * 64 + lc8;  \
    rq0 = NTL4(tb); rq1 = NTL4(tb + 2048);                                                                            \
    ro0 = NTL4(tb + 4096); ro1 = NTL4(tb + 4096 + 2048);                                                              \
    rd0 = NTL4(tb + 8192); rd1 = NTL4(tb + 8192 + 2048);                                                              \
    if (m) { rm0 = NTL4(tb + 12288); rm1 = NTL4(tb + 12288 + 2048); }                                                 \
    if (tid < 64) rrs = ((const float*)(P.ws + W_AUX))[(size_t)(m * 1024 + u1) * 128 + tid];                         \
  }
  const int et = tid >> 2, eq = tid & 3, ecol0 = h * 64 + 16 * eq;
  const int egcol = (m == 0 ? C_GLA_GATE : (m == 1 ? C_GDN_GATE : C_RW_GATE)) + ecol0;
  float* cgL = (float*)(lds + 36864 + 16640 + 256);
  if (tid < 64) {
    const float* gn0 = opq(P.in[13]); const float* gn1 = opq(P.in[27]);
    float g_ = 0.f, b_ = 0.f, m_ = 0.f;
    if (m == 0) g_ = gn0[layer * 64 + tid];
    else if (m == 1) g_ = gn1[layer * 64 + tid];
    else { g_ = P.in[36][layer * 256 + h * 64 + tid]; b_ = P.in[37][layer * 256 + h * 64 + tid]; m_ = P.in[28][layer * 896 + 512 + h * 64 + tid]; }
    cgL[tid] = g_; cgL[64 + tid] = b_; cgL[128 + tid] = m_;
  }
  const float* cg = cgL + 16 * eq; const float* cb = cgL + 64 + 16 * eq; const float* cm = cgL + 128 + 16 * eq;
  uint4 eg0, eg1, ex0, ex1, ep0, ep1, ng0, ng1, nx0, nx1, np0, np1;
  float bonus = 0.f, nbonus = 0.f;
  ex0 = make_uint4(0, 0, 0, 0); ex1 = ex0; ep0 = ex0; ep1 = ex0; nx0 = ex0; nx1 = ex0; np0 = ex0; np1 = ex0;
#define M2_ELOAD(cc)                                                                                                  \
  {                                                                                                                   \
    const u16* prow = proj + (size_t)(b * 2048 + (cc) * 64 + et) * PSTR;                                              \
    ng0 = *(const uint4*)(prow + egcol); ng1 = *(const uint4*)(prow + egcol + 8);                                     \
    if (m == 2) {                                                                                                     \
      nx0 = *(const uint4*)(prow + C_RW_V + ecol0); nx1 = *(const uint4*)(prow + C_RW_V + ecol0 + 8);                 \
      if ((cc) * 64 + et > 0) { np0 = *(const uint4*)(prow - PSTR + C_RW_V + ecol0); np1 = *(const uint4*)(prow - PSTR + C_RW_V + ecol0 + 8); } \
      else { np0 = make_uint4(0, 0, 0, 0); np1 = np0; }                                                               \
      nbonus = ((const float*)(P.ws + W_AUX))[(size_t)(m * 1024 + u0 + (cc)) * 128 + 64 + et];                        \
    }                                                                                                                 \
  }
  M2_GLOAD(0);
  M2_ELOAD(0);
  for (int c = 0; c < 32; ++c) {
    eg0 = ng0; eg1 = ng1; ex0 = nx0; ex1 = nx1; ep0 = np0; ep1 = np1; bonus = nbonus;
    *(uint4*)(QdT + lrow * 72 + lc8) = rq0; *(uint4*)(QdT + (lrow + 32) * 72 + lc8) = rq1;
    *(uint4*)(OlT + lrow * 72 + lc8) = ro0; *(uint4*)(OlT + (lrow + 32) * 72 + lc8) = ro1;
    *(uint4*)(dST + lrow * 72 + lc8) = rd0; *(uint4*)(dST + (lrow + 32) * 72 + lc8) = rd1;
    *(uint4*)(McT + lrow * 72 + lc8) = rm0; *(uint4*)(McT + (lrow + 32) * 72 + lc8) = rm1;
    if (tid < 64) rsA[tid] = rrs;
    __syncthreads();
    if (c < 31) { M2_GLOAD(c + 1); M2_ELOAD(c + 1); }
    f32x4 o[4], sn[4];
#pragma unroll
    for (int mt = 0; mt < 4; ++mt)
#pragma unroll
      for (int i = 0; i < 4; ++i) {
        const int row = mt * 16 + 4 * g4 + i;
        o[mt][i] = bf2f(OlT[row * 72 + 16 * wv + l16]);
        sn[mt][i] = rsA[row] * S[mt][i] + bf2f(dST[row * 72 + 16 * wv + l16]);
      }
    bf16x8 bS[2];
#pragma unroll
    for (int ks = 0; ks < 2; ++ks) {
      typedef __attribute__((ext_vector_type(4))) unsigned u32x4;
      u32x4 pk;
      pk[0] = pk2(S[2 * ks][0], S[2 * ks][1]); pk[1] = pk2(S[2 * ks][2], S[2 * ks][3]);
      pk[2] = pk2(S[2 * ks + 1][0], S[2 * ks + 1][1]); pk[3] = pk2(S[2 * ks + 1][2], S[2 * ks + 1][3]);
      bS[ks] = __builtin_bit_cast(bf16x8, pk);
    }
#pragma unroll
    for (int mt = 0; mt < 4; ++mt)
#pragma unroll
      for (int ks = 0; ks < 2; ++ks) {
        const bf16x4 lo = *(const bf16x4*)(QdT + (mt * 16 + l16) * 72 + ks * 32 + 4 * g4);
        const bf16x4 hi = *(const bf16x4*)(QdT + (mt * 16 + l16) * 72 + ks * 32 + 16 + 4 * g4);
        const bf16x8 a = __builtin_shufflevector(lo, hi, 0, 1, 2, 3, 4, 5, 6, 7);
        o[mt] = MFMA16(a, bS[ks], o[mt]);
        if (m) {
          const bf16x4 lo2 = *(const bf16x4*)(McT + (mt * 16 + l16) * 72 + ks * 32 + 4 * g4);
          const bf16x4 hi2 = *(const bf16x4*)(McT + (mt * 16 + l16) * 72 + ks * 32 + 16 + 4 * g4);
          const bf16x8 a2 = __builtin_shufflevector(lo2, hi2, 0, 1, 2, 3, 4, 5, 6, 7);
          sn[mt] = MFMA16(a2, bS[ks], sn[mt]);
        }
      }
#pragma unroll
    for (int mt = 0; mt < 4; ++mt) {
      S[mt] = sn[mt];
#pragma unroll
      for (int i = 0; i < 4; ++i) Ot[(mt * 16 + 4 * g4 + i) * 65 + 16 * wv + l16] = o[mt][i];
    }
    __syncthreads();
    {
      const int tok = b * 2048 + c * 64 + et;
      float ov[16];
#pragma unroll
      for (int j = 0; j < 16; ++j) ov[j] = Ot[et * 65 + 16 * eq + j];
      float sm = 0.f, ss = 0.f;
#pragma unroll
      for (int j = 0; j < 16; ++j) { sm += ov[j]; ss += ov[j] * ov[j]; }
      sm = qsum(sm); ss = qsum(ss);
      const float mu = m == 2 ? sm * (1.f / 64.f) : 0.f;
      const float r = m == 2 ? rsqrtf(fmaxf(ss * (1.f / 64.f) - mu * mu, 0.f) + 64e-5f) : rsqrtf(ss * (1.f / 64.f) + 1e-6f);
      float gate[16], outv[16];
      unpk8(eg0, gate); unpk8(eg1, gate + 8);
      if (m == 2) {
        float xv[16], pv[16];
        unpk8(ex0, xv); unpk8(ex1, xv + 8); unpk8(ep0, pv); unpk8(ep1, pv + 8);
#pragma unroll
        for (int j = 0; j < 16; ++j) {
          const float vs = xv[j] + (pv[j] - xv[j]) * cm[j];
          outv[j] = ((ov[j] - mu) * r * cg[j] + cb[j] + bonus * vs) * silu(gate[j]);
        }
      } else {
#pragma unroll
        for (int j = 0; j < 16; ++j) outv[j] = ov[j] * r * cg[j] * silu(gate[j]);
      }
      u16* mixed = (u16*)(P.ws + W_HB);
      st16(mixed + (size_t)tok * 1024 + (m == 0 ? 0 : (m == 1 ? 512 : 768)) + ecol0, outv);
    }
  }
#undef M2_GLOAD
#undef M2_ELOAD
  const size_t sbase = ((size_t)(layer * 8 + b) * 4 + h) * 4096;
  float* sout = P.out + (m == 0 ? O_GLA_P : (m == 1 ? O_GDN_P : O_RW_P)) + sbase;
#pragma unroll
  for (int kt = 0; kt < 4; ++kt)
#pragma unroll
    for (int i = 0; i < 4; ++i) {
      const int k = kt * 16 + 4 * g4 + i, v = 16 * wv + l16;
      if (m == 2) sout[v * 64 + k] = S[kt][i]; else sout[k * 64 + v] = S[kt][i];
    }
  __syncthreads();
}

DI void s5_unit(const Params& P, int layer, int kind, bool sample, int bs, int c, int ghalf, char* lds) {
  int tid_ = threadIdx.x; asm volatile("" : "+v"(tid_));
  const int tid = tid_, wave = tid >> 6, lane = tid & 63, l16 = lane & 15, g4 = lane >> 4;
  u16* BUw = (u16*)lds + wave * 2176;
  u16* Hw = (u16*)(lds + 17408) + wave * 2176;
  u16* Yt = (u16*)(lds + 34816);
  const u16* proj = (const u16*)(P.ws + W_PROJ);
  const float* sp = (const float*)(P.ws + W_S5P);
  const u16* bbt = (const u16*)(P.ws + W_S5P + 16384);
  const u16* cmt = bbt + 16 * 128 * 16;
  const int tok0 = sample ? TP + bs * 64 : bs * 2048 + c * 64;
  const bf16x8 zero8 = (bf16x8){0, 0, 0, 0, 0, 0, 0, 0};
  const int ngi = kind == 0 ? 2 : 4;
  for (int gi = 0; gi < ngi; ++gi) {
    const int g = kind == 0 ? ghalf * 8 + wave * 2 + gi : wave * 4 + gi;
    const int p = lane;
    const float abr = sp[g * 64 + p], abi = sp[1024 + g * 64 + p];
    bf16x8 bfr[8], cfr[4];
#pragma unroll
    for (int nt = 0; nt < 8; ++nt) bfr[nt] = g4 < 2 ? *(const bf16x8*)(bbt + (g * 128 + nt * 16 + l16) * 16 + g4 * 8) : zero8;
#pragma unroll
    for (int ks = 0; ks < 4; ++ks) cfr[ks] = *(const bf16x8*)(cmt + (g * 16 + l16) * 128 + ks * 32 + g4 * 8);
    float hr = 0.f, hi = 0.f;
    if (kind == 1 && !sample) {
      const float lr = sp[2048 + g * 64 + p], li = sp[3072 + g * 64 + p];
      const float* E = (const float*)(P.ws + W_S5E) + ((size_t)(bs * 32) * 16 + g) * 128;
      for (int c2 = 0; c2 < c; ++c2) {
        const float er = E[(size_t)c2 * 2048 + p], ei = E[(size_t)c2 * 2048 + 64 + p];
        const float nr = lr * hr - li * hi + er, ni = lr * hi + li * hr + ei;
        hr = nr; hi = ni;
      }
    }
    const float dch = P.in[21][layer * 256 + g * 16 + l16];
    bf16x8 afr[4];
    u16 uraw[16];
#pragma unroll
    for (int sub = 0; sub < 4; ++sub) {
      afr[sub] = g4 < 2 ? *(const bf16x8*)(proj + (size_t)(tok0 + sub * 16 + l16) * PSTR + C_S5_U + g * 16 + g4 * 8) : zero8;
#pragma unroll
      for (int i = 0; i < 4; ++i) uraw[sub * 4 + i] = (kind == 1) ? proj[(size_t)(tok0 + sub * 16 + 4 * g4 + i) * PSTR + C_S5_U + g * 16 + l16] : (u16)0;
    }
#pragma unroll
    for (int sub = 0; sub < 4; ++sub) {
      {
        const bf16x8 a = afr[sub];
#pragma unroll
        for (int nt = 0; nt < 8; ++nt) {
          f32x4 acc = (f32x4){0.f, 0.f, 0.f, 0.f};
          acc = MFMA16(a, bfr[nt], acc);
#pragma unroll
          for (int i = 0; i < 4; ++i) BUw[(4 * g4 + i) * 136 + nt * 16 + l16] = f2bf(acc[i]);
        }
      }
      float s0r[16], s0i[16];
      if (sample) {
#pragma unroll
        for (int tt = 0; tt < 16; ++tt) {
          const size_t si = (((size_t)layer * 128 + bs * 64 + sub * 16 + tt) * 16 + g) * 64 + p;
          s0r[tt] = P.in[3][si]; s0i[tt] = P.in[4][si];
        }
      }
      __builtin_amdgcn_fence(__ATOMIC_ACQ_REL, "wavefront"); __builtin_amdgcn_wave_barrier();
#pragma unroll
      for (int tt = 0; tt < 16; ++tt) {
        const float br = bf2f(BUw[tt * 136 + p]), bi = bf2f(BUw[tt * 136 + 64 + p]);
        if (sample) { hr = s0r[tt]; hi = s0i[tt]; }
        const float nr = abr * hr - abi * hi + br, ni = abr * hi + abi * hr + bi;
        hr = nr; hi = ni;
        if (kind == 1) { Hw[tt * 136 + p] = f2bf(hr); Hw[tt * 136 + 64 + p] = f2bf(hi); }
        if (sample) {
          const size_t si = (((size_t)layer * 128 + bs * 64 + sub * 16 + tt) * 16 + g) * 64 + p;
          P.out[O_S5R_S + si] = hr; P.out[O_S5I_S + si] = hi;
        }
      }
      __builtin_amdgcn_fence(__ATOMIC_ACQ_REL, "wavefront"); __builtin_amdgcn_wave_barrier();
      if (kind == 1) {
        f32x4 y = (f32x4){0.f, 0.f, 0.f, 0.f};
#pragma unroll
        for (int ks = 0; ks < 4; ++ks) {
          const bf16x8 a = *(const bf16x8*)(Hw + l16 * 136 + ks * 32 + g4 * 8);
          y = MFMA16(a, cfr[ks], y);
        }
#pragma unroll
        for (int i = 0; i < 4; ++i) {
          const int trow = sub * 16 + 4 * g4 + i;
          const float u = bf2f(uraw[sub * 4 + i]);
          const float yv = y[i] + dch * u;
          const float ge = 0.5f * yv * (1.f + ftanh(0.7978845608028654f * (yv + 0.044715f * yv * yv * yv)));
          Yt[trow * 264 + g * 16 + l16] = f2bf(ge);
        }
      }
    }
    if (kind == 0) {
      float* E = (float*)(P.ws + W_S5E) + ((size_t)(bs * 32 + c) * 16 + g) * 128;
      E[p] = hr; E[64 + p] = hi;
    } else if (!sample && c == 31) {
      const size_t si = (((size_t)layer * 8 + bs) * 16 + g) * 64 + p;
      P.out[O_S5R_P + si] = hr; P.out[O_S5I_P + si] = hi;
    }
  }
  __syncthreads();
  if (kind == 1) {
    const u16* wg = (const u16*)(P.ws + W_WGLU);
    f32x4 acc[4][4];
#pragma unroll
    for (int i = 0; i < 4; ++i)
#pragma unroll
      for (int j = 0; j < 4; ++j) acc[i][j] = (f32x4){0.f, 0.f, 0.f, 0.f};
    for (int ks = 0; ks < 8; ++ks) {
      bf16x8 a[4], bb[4];
#pragma unroll
      for (int mt = 0; mt < 4; ++mt) a[mt] = *(const bf16x8*)(Yt + (mt * 16 + l16) * 264 + ks * 32 + g4 * 8);
#pragma unroll
      for (int nt = 0; nt < 4; ++nt) bb[nt] = *(const bf16x8*)(wg + (size_t)(64 * wave + nt * 16 + l16) * 256 + ks * 32 + g4 * 8);
#pragma unroll
      for (int mt = 0; mt < 4; ++mt)
#pragma unroll
        for (int nt = 0; nt < 4; ++nt) acc[mt][nt] = MFMA16(a[mt], bb[nt], acc[mt][nt]);
    }
    u16* mixed = (u16*)(P.ws + W_HB);
#pragma unroll
    for (int nt = 0; nt < 4; ++nt) {
      const int n = 64 * wave + nt * 16 + l16;
      const float bgl = P.in[23][layer * 256 + n];
#pragma unroll
      for (int mt = 0; mt < 4; ++mt)
#pragma unroll
        for (int i = 0; i < 4; ++i) {
          const int trow = mt * 16 + 4 * g4 + i;
          const float yv = bf2f(Yt[trow * 264 + n]);
          const float gate = bf2f(proj[(size_t)(tok0 + trow) * PSTR + C_S5_GATE + n]);
          mixed[(size_t)(tok0 + trow) * 1024 + 256 + n] = f2bf(yv * sigm(acc[mt][nt][i] + bgl) * silu(gate));
        }
    }
  }
  __syncthreads();
}

DI void step_unit_w(const Params& P, int layer, int m, int seq, char* lds) {
  int tid_ = threadIdx.x; asm volatile("" : "+v"(tid_));
  const int tid = tid_, h = tid >> 6, lane = tid & 63, hd = h * 64 + lane;
  float* vecs = (float*)lds + h * 320;
  const int tok = TP + seq;
  const u16* prow = (const u16*)(P.ws + W_PROJ) + (size_t)tok * PSTR;
  const size_t sbase = ((size_t)(layer * 128 + seq) * 4 + h) * 4096;
  const float* si0 = opq(P.in[2]); const float* si1 = opq(P.in[5]); const float* si2 = opq(P.in[7]);
  const float* sin = (m == 0 ? si0 : (m == 1 ? si1 : si2)) + sbase;
  float* sout = P.out + (m == 0 ? O_GLA_S : (m == 1 ? O_GDN_S : O_RW_S)) + sbase;
  float S[64];
  if (m == 2) {
#pragma unroll
    for (int i = 0; i < 16; ++i) {
      const f32x4 x = __builtin_nontemporal_load((const f32x4*)(sin + lane * 64 + 4 * i));
      S[4 * i] = x[0]; S[4 * i + 1] = x[1]; S[4 * i + 2] = x[2]; S[4 * i + 3] = x[3];
    }
  } else {
#pragma unroll
    for (int k = 0; k < 64; ++k) S[k] = __builtin_nontemporal_load(sin + k * 64 + lane);
  }
  float al = 0.f, be = 0.f, kr = 0.f, qv = 0.f, vv = 0.f, w = 1.f, bonus = 0.f;
  int gcol;
  if (m == 0) {
    gcol = C_GLA_GATE + hd;
    const float q = bf2f(prow[C_GLA_Q + hd]), k = bf2f(prow[C_GLA_K + hd]);
    vv = bf2f(prow[C_GLA_V + hd]);
    float x = P.in[12][layer * 256 + hd];
    const float* wg = P.in[11] + (size_t)layer * 16 * 256 + hd;
#pragma unroll
    for (int r = 0; r < 16; ++r) x += bf2f(prow[C_GLA_GLR + r]) * wg[r * 256];
    w = __expf(-softplus(-x) * (1.f / 16.f));
    kr = k; qv = q * 0.125f;
  } else if (m == 1) {
    gcol = C_GDN_GATE + hd;
    const float* cst = P.in[6] + ((size_t)layer * 128 + seq) * 2304;
    const float* cw = P.in[24] + (size_t)layer * 3072;
    float qkv[3];
#pragma unroll
    for (int part = 0; part < 3; ++part) {
      const int col = part * 256 + hd;
      float acc = bf2f(prow[C_GDN_Q + col]) * cw[3 * 768 + col];
#pragma unroll
      for (int jj = 1; jj <= 3; ++jj) acc += cst[(3 - jj) * 768 + col] * cw[(3 - jj) * 768 + col];
      qkv[part] = silu(acc);
    }
    const float sq = wsum(qkv[0] * qkv[0]), sk = wsum(qkv[1] * qkv[1]);
    const float rq = rsqrtf(sq + 1e-6f) * 0.125f, rk = rsqrtf(sk + 1e-6f);
    const float a_raw = bf2f(prow[C_GDN_A + h]), b_raw = bf2f(prow[C_GDN_B + h]);
    const float gg = -__expf(P.in[25][layer * 4 + h]) * softplus(a_raw + P.in[26][layer * 4 + h]);
    const float beta = sigm(b_raw), eg = __expf(gg);
    const float k = qkv[1] * rk;
    al = k; be = -eg * beta * k; kr = beta * k; qv = qkv[0] * rq; vv = qkv[2]; w = eg;
  } else {
    gcol = C_RW_GATE + hd;
    const float* sst = P.in[8] + ((size_t)layer * 128 + seq) * 896;
    const float* mu = P.in[28] + layer * 896;
    float xs[5];
#pragma unroll
    for (int part = 0; part < 5; ++part) {
      const int col = part < 3 ? part * 256 + hd : (part == 3 ? 768 + lane : 832 + lane);
      const float x = bf2f(prow[C_RW_R + col]);
      xs[part] = x + (sst[col] - x) * mu[col];
    }
    const float twl = ftanh(xs[3]), tal = xs[4];
    const float* ww2 = P.in[30] + (size_t)layer * 64 * 256 + hd;
    const float* wa2 = P.in[32] + (size_t)layer * 64 * 256 + hd;
    float wl = 0.f, alr = 0.f;
#pragma unroll 8
    for (int r = 0; r < 64; ++r) { wl += __shfl(twl, r) * ww2[r * 256]; alr += __shfl(tal, r) * wa2[r * 256]; }
    const float wraw = -softplus(-(P.in[29][layer * 256 + hd] + wl)) - 0.5f;
    w = __expf(-__expf(wraw));
    const float a = sigm(P.in[31][layer * 256 + hd] + alr);
    const float kkv = xs[1] * P.in[33][layer * 256 + hd];
    const float kk = kkv * rsqrtf(wsum(kkv * kkv) + 1e-6f);
    kr = xs[1] * (1.f + (a - 1.f) * P.in[34][layer * 256 + hd]);
    bonus = wsum(xs[0] * kr * P.in[35][layer * 256 + hd]);
    al = kk; be = -(kk * a); qv = xs[0]; vv = xs[2];
  }
  vecs[lane] = al; vecs[64 + lane] = be; vecs[128 + lane] = kr; vecs[192 + lane] = qv; vecs[256 + lane] = w;
  __builtin_amdgcn_fence(__ATOMIC_ACQ_REL, "wavefront"); __builtin_amdgcn_wave_barrier();
  float z = 0.f;
#pragma unroll
  for (int k = 0; k < 64; ++k) z += vecs[k] * S[k];
  float o = 0.f;
#pragma unroll
  for (int k = 0; k < 64; ++k) {
    S[k] = vecs[256 + k] * S[k] + vecs[64 + k] * z + vecs[128 + k] * vv;
    o += vecs[192 + k] * S[k];
  }
  if (m == 2) {
#pragma unroll
    for (int i = 0; i < 16; ++i) {
      const f32x4 x = {S[4 * i], S[4 * i + 1], S[4 * i + 2], S[4 * i + 3]};
      __builtin_nontemporal_store(x, (f32x4*)(sout + lane * 64 + 4 * i));
    }
  } else {
#pragma unroll
    for (int k = 0; k < 64; ++k) __builtin_nontemporal_store(S[k], sout + k * 64 + lane);
  }
  const float gate = bf2f(prow[gcol]);
  float outv;
  if (m < 2) {
    const float* gn0 = opq(P.in[13]); const float* gn1 = opq(P.in[27]);
    const float gn = (m == 0 ? gn0 : gn1)[layer * 64 + lane];
    const float r = rsqrtf(wsum(o * o) * (1.f / 64.f) + 1e-6f);
    outv = o * r * gn * silu(gate);
  } else {
    const float mu_ = wsum(o) * (1.f / 64.f);
    const float dv = o - mu_;
    const float r = rsqrtf(wsum(dv * dv) * (1.f / 64.f) + 64e-5f);
    outv = (dv * r * P.in[36][layer * 256 + hd] + P.in[37][layer * 256 + hd] + bonus * vv) * silu(gate);
  }
  u16* mixed = (u16*)(P.ws + W_HB);
  mixed[(size_t)tok * 1024 + (m == 0 ? 0 : (m == 1 ? 512 : 768)) + hd] = f2bf(outv);
  if (m == 1) {
    const float* cst = P.in[6] + ((size_t)layer * 128 + seq) * 2304;
    float* co = P.out + O_CONV_S + ((size_t)layer * 128 + seq) * 2304;
    for (int e = tid; e < 2304; e += 256) {
      const int rrow = e / 768, cc = e % 768;
      co[e] = rrow < 2 ? cst[(rrow + 1) * 768 + cc] : bf2f(prow[C_GDN_Q + cc]);
    }
  }
  if (m == 2) {
    float* so = P.out + O_SH_S + ((size_t)layer * 128 + seq) * 896;
    for (int e = tid; e < 896; e += 256) so[e] = bf2f(prow[C_RW_R + e]);
  }
  __syncthreads();
}

DI void phase_mix(const Params& P, int layer, int second, char* lds) {
  if (second && blockIdx.x < 96) {
    const int u = blockIdx.x;
    m2_unit(P, layer, u >> 5, (u & 31) >> 2, u & 3, lds);
    return;
  }
  const int u0 = second ? blockIdx.x - 96 : blockIdx.x;
  const int stride = second ? gridDim.x - 96 : gridDim.x;
  const int n = second ? 258 + 384 : 3072 + 512;
  for (int u = u0; u < n; u += stride) {
    const bool is_s5 = second ? (u < 258) : (u >= 3072);
    if (is_s5) {
      const int v = second ? u : u - 3072;
      const bool smp = second && v >= 256;
      if (!second) s5_unit(P, layer, 0, false, v >> 6, (v >> 1) & 31, v & 1, lds);
      else if (!smp) s5_unit(P, layer, 1, false, v >> 5, v & 31, 0, lds);
      else s5_unit(P, layer, 1, true, v - 256, 0, 0, lds);
    } else if (second) {
      const int v = u - 258;
      step_unit_w(P, layer, v >> 7, v & 127, lds);
    } else {
      const int r = u & 1023;
      mix_unit(P, layer, 2 - (u >> 10), 0, r >> 7, (r >> 5) & 3, r & 31, lds);
    }
  }
}
DI void phase_final(const Params& P) {
  int tid_ = threadIdx.x; asm volatile("" : "+v"(tid_));
  const int tid = tid_, wave = tid >> 6, lane = tid & 63;
  const float* g = P.in[39];
  int r = blockIdx.x * 4 + wave;
  float4 v[4], nv[4];
  if (r < TT) {
    const float4* x = (const float4*)(P.out + (size_t)r * 1024);
#pragma unroll
    for (int i = 0; i < 4; ++i) { const f32x4 t_ = __builtin_nontemporal_load((const f32x4*)(x + lane + 64 * i)); v[i] = make_float4(t_[0], t_[1], t_[2], t_[3]); }
  }
  for (; r < TT; r += gridDim.x * 4) {
    const int rn = r + gridDim.x * 4;
    if (rn < TT) {
      const float4* xn = (const float4*)(P.out + (size_t)rn * 1024);
#pragma unroll
      for (int i = 0; i < 4; ++i) { const f32x4 t_ = __builtin_nontemporal_load((const f32x4*)(xn + lane + 64 * i)); nv[i] = make_float4(t_[0], t_[1], t_[2], t_[3]); }
    }
    float4* x = (float4*)(P.out + (size_t)r * 1024);
    if (r >= TP) {
      const float4* pp = (const float4*)(P.ws + W_PART) + (size_t)(r - TP) * 256;
#pragma unroll
      for (int kq = 0; kq < 4; ++kq)
#pragma unroll
        for (int i = 0; i < 4; ++i) {
          const float4 pv = pp[(size_t)kq * 128 * 256 + lane + 64 * i];
          v[i].x += pv.x; v[i].y += pv.y; v[i].z += pv.z; v[i].w += pv.w;
        }
    }
    float ss = 0.f;
#pragma unroll
    for (int i = 0; i < 4; ++i) ss += v[i].x * v[i].x + v[i].y * v[i].y + v[i].z * v[i].z + v[i].w * v[i].w;
    ss = wsum(ss);
    const float rs = rsqrtf(ss * (1.f / 1024.f) + 1e-6f);
#pragma unroll
    for (int i = 0; i < 4; ++i) {
      float4 gg = ((const float4*)g)[lane + 64 * i];
      { const f32x4 yv = {v[i].x * rs * gg.x, v[i].y * rs * gg.y, v[i].z * rs * gg.z, v[i].w * rs * gg.w}; __builtin_nontemporal_store(yv, (f32x4*)(x + lane + 64 * i)); }
    }
#pragma unroll
    for (int i = 0; i < 4; ++i) v[i] = nv[i];
  }
}

#define XB_TMO      128
#define XB_XCNT(j)  (256  + 64 * (j))
#define XB_XSUB(j)  (1280 + 64 * (j))
#define XB_XGEN(j)  (2304 + 64 * (j))
#define XB_TOP      3328
#define XB_TOPGEN   3392
#define XCD_BAR_WORDS 3456
#define XB_SPIN_CAP (1u << 22)
#define LAS __attribute__((address_space(3)))
DI unsigned xb_ld(unsigned* p) { return __hip_atomic_load(p, __ATOMIC_RELAXED, __HIP_MEMORY_SCOPE_AGENT); }
DI unsigned xb_add(unsigned* p, unsigned v) { return __hip_atomic_fetch_add(p, v, __ATOMIC_RELAXED, __HIP_MEMORY_SCOPE_AGENT); }
DI unsigned xb_xcc_id() { return (unsigned)__builtin_amdgcn_s_getreg((3 << 11) | 20) & 0xFu; }
#define XB_SPIN(cond, bar) do { unsigned _sp = 0; while (cond) { __builtin_amdgcn_s_sleep(8); \
    if ((++_sp & 255u) == 0u) { if (xb_ld(&(bar)[XB_TMO])) break; if (_sp > XB_SPIN_CAP) { atomicAdd(&(bar)[XB_TMO], 1u); break; } } } } while (0)
struct XcdBarrier { unsigned* bar; unsigned x; volatile LAS unsigned* st; };
DI XcdBarrier xcd_barrier_post(unsigned* bar, volatile LAS unsigned* st) {
  XcdBarrier b; b.bar = bar; b.x = xb_xcc_id(); b.st = st;
  if (threadIdx.x == 0) (void)xb_add(&bar[XB_XCNT(b.x)], 1u);
  return b;
}
DI void xcd_barrier_complete(unsigned* bar, unsigned x, unsigned& nloc, unsigned& nx) {
  const unsigned G = gridDim.x * gridDim.y * gridDim.z;
  unsigned sum, cnt, mine, sp = 0u;
  for (;;) {
    sum = 0u; cnt = 0u; mine = 0u;
#pragma unroll
    for (unsigned j = 0; j < 16; ++j) { const unsigned c = xb_ld(&bar[XB_XCNT(j)]); sum += c; cnt += (c > 0u) ? 1u : 0u; mine = (j == x) ? c : mine; }
    if (sum == G) break;
    __builtin_amdgcn_s_sleep(1);
    if ((++sp & 255u) == 0u) { if (xb_ld(&bar[XB_TMO])) break; if (sp > XB_SPIN_CAP) { atomicAdd(&bar[XB_TMO], 1u); break; } }
  }
  nloc = mine > 0u ? mine : 1u; nx = cnt > 0u ? cnt : 1u;
}
DI void xcd_barrier(const XcdBarrier& b) {
  asm volatile("s_waitcnt vmcnt(0)" ::: "memory");
  __syncthreads();
  if (threadIdx.x == 0) {
    unsigned* bar = b.bar;
    __builtin_amdgcn_s_waitcnt(0);
    unsigned nloc = b.st[0], nx = b.st[1];
    if (nloc == 0u) { xcd_barrier_complete(bar, b.x, nloc, nx); b.st[0] = nloc; b.st[1] = nx; }
    const unsigned old = xb_add(&bar[XB_XSUB(b.x)], 1u);
    const unsigned gen = old / nloc;
    if (old + 1u == (gen + 1u) * nloc) {
      __builtin_amdgcn_fence(__ATOMIC_RELEASE, "agent");
      asm volatile("s_waitcnt vmcnt(0)" ::: "memory");
      const unsigned og = xb_add(&bar[XB_TOP], 1u);
      const unsigned tg = og / nx;
      if (og + 1u == (tg + 1u) * nx) xb_add(&bar[XB_TOPGEN], 1u);
      else XB_SPIN(xb_ld(&bar[XB_TOPGEN]) == tg, bar);
      __builtin_amdgcn_fence(__ATOMIC_ACQUIRE, "agent");
      xb_add(&bar[XB_XGEN(b.x)], 1u);
      asm volatile("s_waitcnt vmcnt(0)" ::: "memory");
    } else {
      XB_SPIN(xb_ld(&bar[XB_XGEN(b.x)]) == gen, bar);
      __builtin_amdgcn_fence(__ATOMIC_ACQUIRE, "agent");
      asm volatile("s_waitcnt vmcnt(0)" ::: "memory");
    }
  }
  __syncthreads();
}

__global__ void __launch_bounds__(256, 2) mega(Params P, int ph_lo, int ph_hi, int coop) {
  __shared__ __attribute__((aligned(16))) char lds[LDS_BYTES];
  __shared__ uint4 xb_words;
  if (ph_lo < 0) cg::this_grid().sync();
  XcdBarrier xb;
  if (coop) {
    if (threadIdx.x == 0) xb_words = make_uint4(0u, 0u, 0u, 0u);
    __syncthreads();
    xb = xcd_barrier_post((unsigned*)(P.ws + W_BAR), (volatile LAS unsigned*)&xb_words);
  }
  for (int ph = ph_lo; ph < ph_hi; ++ph) {
    if (ph == NPH - 1) phase_final(P);
    else {
      const int layer = ph / PER, k_ = ph % PER;
      const int s = (DUP_S >= 0 && k_ > DUP_S) ? k_ - 1 : k_;
      if (s == 0) phase_norm(P, layer, lds);
      else if (s == 1) phase_gemm1(P, layer, lds);
      else if (s == 2 || s == 3) phase_mix(P, layer, s - 2, lds);
      else phase_gemm2(P, layer, lds);
    }
    if (coop && ph + 1 < ph_hi) xcd_barrier(xb);
  }
}

extern "C" void kernel_launch(void* const* d_in, const int* in_sizes, int n_in, void* d_out, int out_size, void* d_ws,
                              size_t ws_size, hipStream_t stream) {
  static int grid_blocks = 0;
  if (!grid_blocks) {
    int dev = 0, cus = 0, per_cu = 0;
    (void)hipGetDevice(&dev);
    (void)hipDeviceGetAttribute(&cus, hipDeviceAttributeMultiprocessorCount, dev);
    (void)hipOccupancyMaxActiveBlocksPerMultiprocessor(&per_cu, mega, 256, 0);
    if (per_cu < 1) per_cu = 1;
    if (per_cu > 2) per_cu = 2;
    grid_blocks = cus * per_cu;
    if (ws_size < W_END) fprintf(stderr, "workspace too small: %zu < %zu\n", ws_size, (size_t)W_END);
  }
  Params p;
  memset(&p, 0, sizeof(p));
  for (int i = 0; i < 40; ++i) p.in[i] = (const float*)d_in[i];
  p.out = (float*)d_out;
  p.ws = (char*)d_ws;
#if COOP
  (void)hipMemsetAsync((char*)d_ws + W_BAR, 0, 16384, stream);
  int lo = 0, hi = NPH, coop = 1;
  void* args[] = {&p, &lo, &hi, &coop};
  hipError_t e = hipLaunchCooperativeKernel((void*)mega, dim3(grid_blocks), dim3(256), args, 0, stream);
  if (e != hipSuccess) fprintf(stderr, "cooperative launch failed: %s (grid %d)\n", hipGetErrorString(e), grid_blocks);
#else
  for (int ph = 0; ph < NPH; ++ph) mega<<<grid_blocks, 256, 0, stream>>>(p, ph, ph + 1, 0);
#endif
}
```
